# Optimizing an MI355X kernel written in HIP

```python
import jax, jax.numpy as jnp
from jax import lax
import numpy as np

D_MODEL = 2048
BATCH = 2
SEQ = 16384
DEPTH = 1

CTX_LEN = 256
GRID_W = 64
MIX_WIDTH = D_MODEL
HG_WIDTH = D_MODEL // 2
HG_DK = 128
HG_DV = 128
HG_HEADS = HG_WIDTH // HG_DK
CONV_WIDTH = MIX_WIDTH - HG_WIDTH
CONV_K = 3
CHUNK = 64
D_FF = ((8 * D_MODEL // 3 + 255) // 256) * 256
N_IN = 5 * HG_WIDTH + 3 * CONV_WIDTH
ALPHA = (2.0 * DEPTH) ** 0.25
BETA = (8.0 * DEPTH) ** -0.25
LN_EPS = 1e-6
RMS_EPS = 1e-6

kernel_name = "hymba_hgrn2_shortconv_dit_layer"


def layer_norm(x, gain=None, bias=None):
    xf = x.astype(jnp.float32)
    mu = jnp.mean(xf, axis=-1, keepdims=True)
    var = jnp.mean(jnp.square(xf - mu), axis=-1, keepdims=True)
    y = (xf - mu) * lax.rsqrt(var + LN_EPS)
    if gain is not None:
        y = y * gain.astype(jnp.float32) + bias.astype(jnp.float32)
    return y.astype(x.dtype)


def modulate(x, shift, scale):
    return layer_norm(x) * (1 + scale) + shift


def rms_norm(x, w):
    xf = x.astype(jnp.float32)
    return xf * lax.rsqrt(jnp.mean(jnp.square(xf), axis=-1, keepdims=True) + RMS_EPS) * w.astype(jnp.float32)


def lower_bounds(lb_logits, l):
    p = jax.nn.softmax(lb_logits.astype(jnp.float32), axis=1)
    return jnp.cumsum(p, axis=1)[:, l]


def to_dirs(a, n_heads, d):
    B, N, _ = a.shape
    return jnp.stack([a, a[:, ::-1]]).reshape(2 * B, N, n_heads, d)


def hgrn2_kv(p3, lb):
    B, N, _ = p3.shape
    f_raw = p3[..., :2 * HG_WIDTH].astype(jnp.float32)
    f_fwd = lb[0] + (1 - lb[0]) * jax.nn.sigmoid(f_raw[..., :HG_WIDTH])
    f_bwd = lb[1] + (1 - lb[1]) * jax.nn.sigmoid(f_raw[..., HG_WIDTH:])
    f = jnp.stack([f_fwd, f_bwd[:, ::-1]]).reshape(2 * B, N, HG_HEADS, HG_DK)
    v = to_dirs(p3[..., 2 * HG_WIDTH:].astype(jnp.float32), HG_HEADS, HG_DV)
    return 1 - f, jnp.log(f), v


def chunked(a):
    G, N, H, d = a.shape
    return a.reshape(G, N // CHUNK, CHUNK, H, d).transpose(1, 0, 3, 2, 4)


def hgrn2_final_state(k, logf, v):
    G, _, H, _ = k.shape
    S0 = jnp.zeros((G, H, HG_DK, HG_DV), jnp.float32)

    def step(S, inp):
        kc, gc, vc = inp
        b = jnp.cumsum(gc, axis=2)
        b_end = b[:, :, -1:, :]
        S = jnp.swapaxes(jnp.exp(b_end), -1, -2) * S + jnp.einsum('ghsk,ghsv->ghkv', kc * jnp.exp(b_end - b), vc)
        return S, None

    S, _ = lax.scan(step, S0, (chunked(k), chunked(logf), chunked(v)))
    return S


def hgrn2_scan(q, k, logf, v, S0):
    G, N, H, _ = q.shape
    tril = jnp.tril(jnp.ones((CHUNK, CHUNK), dtype=bool))

    def step(S, inp):
        qc, kc, gc, vc = inp
        b = jnp.cumsum(gc, axis=2)
        diff = b[:, :, :, None, :] - b[:, :, None, :, :]
        decay = jnp.exp(jnp.where(tril[:, :, None], diff, -jnp.inf))
        scores = jnp.einsum('ghtk,ghsk,ghtsk->ghts', qc, kc, decay)
        o = jnp.einsum('ghts,ghsv->ghtv', scores, vc) + jnp.einsum('ghtk,ghkv->ghtv', qc * jnp.exp(b), S)
        b_end = b[:, :, -1:, :]
        S = jnp.swapaxes(jnp.exp(b_end), -1, -2) * S + jnp.einsum('ghsk,ghsv->ghkv', kc * jnp.exp(b_end - b), vc)
        return S, o

    S, o = lax.scan(step, S0, (chunked(q), chunked(k), chunked(logf), chunked(v)))
    o = o.transpose(1, 0, 3, 2, 4).reshape(G, N, H, HG_DV)
    return o, S


def dwconv3(z, w, n_segments):
    B, N, C = z.shape
    L = N // n_segments
    zp = jnp.pad(z.reshape(B, n_segments, L, C), ((0, 0), (0, 0), (1, 1), (0, 0)))
    y = w[0] * zp[:, :, :L] + w[1] * zp[:, :, 1:L + 1] + w[2] * zp[:, :, 2:]
    return y.reshape(B, N, C)


def mixer(proj, S0, lb, g_norm_w, conv_w, n_segments):
    B, N, _ = proj.shape
    k_d, logf_d, v_d = hgrn2_kv(proj[..., :3 * HG_WIDTH], lb)
    q_d = to_dirs(jax.nn.silu(proj[..., 3 * HG_WIDTH:4 * HG_WIDTH].astype(jnp.float32)), HG_HEADS, HG_DK)
    o_d, S = hgrn2_scan(q_d, k_d, logf_d, v_d, S0)
    o_d = o_d.reshape(2, B, N, HG_HEADS, HG_DV)
    o = o_d[0] + o_d[1][:, ::-1]
    gate = jax.nn.silu(proj[..., 4 * HG_WIDTH:5 * HG_WIDTH].astype(jnp.float32))
    y_hg = (rms_norm(o, g_norm_w).reshape(B, N, HG_WIDTH) * gate).astype(proj.dtype)
    b_gate, c_gate, xv = jnp.split(proj[..., 5 * HG_WIDTH:], 3, axis=-1)
    y_conv = b_gate * dwconv3(c_gate * xv, conv_w, n_segments)
    return jnp.concatenate([y_hg, y_conv], axis=-1), S


def swiglu(h, w_gate, w_up, w_down):
    return (jax.nn.silu(h @ w_gate) * (h @ w_up)) @ w_down


def trunk_layer(x, xc, c, c_ctx, n_rows, w_mod, b_mod, w_in, lb, g_norm_w, conv_w, w_out,
                ln1_g, ln1_b, w_gate, w_up, w_down, ln2_g, ln2_b, update_ctx):
    mod = jax.nn.silu(c) @ w_mod + b_mod
    mod_c = jax.nn.silu(c_ctx) @ w_mod + b_mod
    sh_a, sc_a, ga_a, sh_f, sc_f, ga_f = jnp.split(mod[:, None, :], 6, axis=-1)
    shc_a, scc_a, gac_a, shc_f, scc_f, gac_f = jnp.split(mod_c, 6, axis=-1)

    hc = modulate(xc, shc_a, scc_a)
    if update_ctx:
        B = xc.shape[0]
        zero_state = jnp.zeros((2 * B, HG_HEADS, HG_DK, HG_DV), jnp.float32)
        yc, S_ctx = mixer(hc @ w_in, zero_state, lb, g_norm_w, conv_w, 1)
        xc = layer_norm(ALPHA * xc + gac_a * (yc @ w_out), ln1_g, ln1_b)
        hc = modulate(xc, shc_f, scc_f)
        xc = layer_norm(ALPHA * xc + gac_f * swiglu(hc, w_gate, w_up, w_down), ln2_g, ln2_b)
    else:
        S_ctx = hgrn2_final_state(*hgrn2_kv(hc @ w_in[:, :3 * HG_WIDTH], lb))

    h = modulate(x, sh_a, sc_a)
    y, _ = mixer(h @ w_in, S_ctx, lb, g_norm_w, conv_w, n_rows)
    x = layer_norm(ALPHA * x + ga_a * (y @ w_out), ln1_g, ln1_b)
    h = modulate(x, sh_f, sc_f)
    x = layer_norm(ALPHA * x + ga_f * swiglu(h, w_gate, w_up, w_down), ln2_g, ln2_b)
    return x, xc


def setup_inputs(seed: int = 0) -> dict:
    key = jax.random.key(seed)
    ks = jax.random.split(key, 20)
    D = D_MODEL
    nrm = jax.random.normal
    return {
        "x": nrm(ks[0], (BATCH, SEQ, D), jnp.float32),
        "c": nrm(ks[1], (BATCH, D), jnp.float32),
        "ctx": nrm(ks[2], (BATCH, CTX_LEN, D), jnp.float32),
        "c_ctx": nrm(ks[3], (D,), jnp.float32),
        "w_mod": nrm(ks[4], (DEPTH, D, 6 * D), jnp.float32) * (0.5 * D ** -0.5),
        "b_mod": nrm(ks[5], (DEPTH, 6 * D), jnp.float32) * 0.01,
        "w_in": nrm(ks[6], (DEPTH, D, N_IN), jnp.float32) * D ** -0.5,
        "lb_logits": nrm(ks[7], (2, DEPTH + 1, HG_WIDTH), jnp.float32) * 0.5,
        "g_norm_w": 1.0 + 0.01 * nrm(ks[8], (DEPTH, HG_DV), jnp.float32),
        "conv_w": nrm(ks[9], (DEPTH, CONV_K, CONV_WIDTH), jnp.float32) * CONV_K ** -0.5,
        "w_out": nrm(ks[10], (DEPTH, MIX_WIDTH, D), jnp.float32) * (BETA * MIX_WIDTH ** -0.5),
        "ln1_g": 1.0 + 0.01 * nrm(ks[11], (DEPTH, D), jnp.float32),
        "ln1_b": 0.01 * nrm(ks[12], (DEPTH, D), jnp.float32),
        "w_gate": nrm(ks[13], (DEPTH, D, D_FF), jnp.float32) * D ** -0.5,
        "w_up": nrm(ks[14], (DEPTH, D, D_FF), jnp.float32) * D ** -0.5,
        "w_down": nrm(ks[15], (DEPTH, D_FF, D), jnp.float32) * (BETA * D_FF ** -0.5),
        "ln2_g": 1.0 + 0.01 * nrm(ks[16], (DEPTH, D), jnp.float32),
        "ln2_b": 0.01 * nrm(ks[17], (DEPTH, D), jnp.float32),
    }


def reference(x, c, ctx, c_ctx, w_mod, b_mod, w_in, lb_logits, g_norm_w, conv_w, w_out,
              ln1_g, ln1_b, w_gate, w_up, w_down, ln2_g, ln2_b):
    n_rows = x.shape[1] // GRID_W
    xc = ctx
    for l in range(DEPTH):
        lb = lower_bounds(lb_logits, l)
        x, xc = trunk_layer(x, xc, c, c_ctx, n_rows, w_mod[l], b_mod[l], w_in[l], lb, g_norm_w[l],
                            conv_w[l], w_out[l], ln1_g[l], ln1_b[l], w_gate[l], w_up[l], w_down[l],
                            ln2_g[l], ln2_b[l], l < DEPTH - 1)
    return x
```

```cpp
#include <hip/hip_runtime.h>
#include <hip/hip_cooperative_groups.h>
#include <cstdio>
namespace cg = cooperative_groups;

#ifndef ONE_LAUNCH
#define ONE_LAUNCH 1
#endif

#define PG8_LAS __attribute__((address_space(3)))
typedef unsigned short bf16_t;
typedef short bf16x8 __attribute__((ext_vector_type(8)));
typedef float f32x4 __attribute__((ext_vector_type(4)));
typedef float f32x2 __attribute__((ext_vector_type(2)));
typedef unsigned u32x4 __attribute__((ext_vector_type(4)));
typedef unsigned u32x2 __attribute__((ext_vector_type(2)));
typedef _Float16 h16x2 __attribute__((ext_vector_type(2)));

constexpr int D = 2048, T = 32768, TALL = 33280, SEQ = 16384, CTXL = 256, HW = 1024, NIN = 8192, DFF = 5632, NGU = 11264;
constexpr float ALPHA = 1.189207115002721f, LN_EPS = 1e-6f, RMS_EPS = 1e-6f;

constexpr size_t WS_WIN = 0;
constexpr size_t WS_WOUT = WS_WIN + (size_t)NIN * D * 2;
constexpr size_t WS_WGU = WS_WOUT + (size_t)D * D * 2;
constexpr size_t WS_WDN = WS_WGU + (size_t)NGU * D * 2;
constexpr size_t WS_MOD = WS_WDN + (size_t)D * DFF * 2;
constexpr size_t WS_LB = WS_MOD + 3 * 12288 * 4;
constexpr size_t WS_STATS = WS_LB + 2048 * 4;
constexpr size_t WS_SEG = WS_STATS + (size_t)T * 8;
constexpr size_t WS_SEGDEC = WS_SEG + (size_t)32 * 8 * 65536;
constexpr size_t WS_H = WS_SEGDEC + 32 * 8 * 128 * 4;
constexpr size_t WS_V = WS_H + (size_t)TALL * D * 2;
constexpr size_t WS_Q = WS_V + (size_t)TALL * HW * 2;
constexpr size_t WS_GATE = WS_Q + (size_t)T * HW * 2;
constexpr size_t WS_BG = WS_GATE + (size_t)T * HW * 2;
constexpr size_t WS_U1 = WS_V;
constexpr size_t WS_P = WS_BG + (size_t)T * HW * 2;
constexpr size_t WS_G = WS_P + (size_t)T * HW * 2;
constexpr size_t WS_Y = WS_G;
constexpr size_t WS_O = WS_G + (size_t)TALL * D * 2;
constexpr size_t WS_HID = WS_P;
constexpr size_t WS_BAR = WS_HID + (size_t)T * DFF * 2;
constexpr size_t WS_END = WS_BAR + 16384;
static_assert(WS_O + (size_t)2 * T * HW * 2 <= WS_END, "ws map");
static_assert(WS_U1 + (size_t)T * D * 4 <= WS_P, "ws map u1");

typedef __bf16 bf16v2_t __attribute__((ext_vector_type(2)));
__device__ __forceinline__ unsigned cvt_pk_bf16(float lo, float hi) { const bf16v2_t v = __builtin_convertvector((f32x2){lo, hi}, bf16v2_t); return __builtin_bit_cast(unsigned, v); }
__device__ __forceinline__ float bf2f(unsigned short b) { return __uint_as_float(((unsigned)b) << 16); }
__device__ __forceinline__ float h2f(unsigned short b) { return (float)__builtin_bit_cast(_Float16, b); }
__device__ __forceinline__ unsigned pk_h2(float a, float b) { h16x2 v; v.x = (_Float16)a; v.y = (_Float16)b; return __builtin_bit_cast(unsigned, v); }
__device__ __forceinline__ void unpack_h8(const u32x4 w, float (&f)[8]) {
#pragma unroll
    for (int i = 0; i < 4; ++i) { const h16x2 h = __builtin_bit_cast(h16x2, (unsigned)w[i]); f[2 * i] = (float)h.x; f[2 * i + 1] = (float)h.y; }
}
__device__ __forceinline__ float silu_f(float v) { return v * __builtin_amdgcn_rcpf(1.0f + __expf(-v)); }
__device__ __forceinline__ float wave_sum(float v) {
#pragma unroll
    for (int o = 1; o < 64; o <<= 1) v += __shfl_xor(v, o);
    return v;
}

namespace pg8 {
constexpr int BM = 256, BK = 64, HALF = 128, HTB = HALF * BK * 2, STAGE_BYTES = 8 * HTB, NXCD = 8, WGM = 8;
__host__ __device__ __forceinline__ int lds_byte(int r, int c) { const int st = (r >> 4) * 2 + (c >> 5), rr = r & 15, cc = c & 31, ob = rr * 64 + cc * 2; return st * 1024 + (ob ^ (((ob >> 9) & 1) << 5)); }
__host__ __device__ __forceinline__ void stage_rc(int b, int& R, int& C) { const int st = b / 1024, sb = b % 1024, swz = sb ^ (((sb >> 9) & 1) << 5); R = (st >> 1) * 16 + swz / 64; C = (st & 1) * 32 + (swz % 64) / 2; }
__host__ __device__ __forceinline__ int perm32(int rho) { const int n = rho >> 4, i = rho & 15; return 8 * (i >> 2) + 4 * n + (i & 3); }
struct Unit { int pm, pn; };
struct Gemm { const bf16_t* A; const bf16_t* Bt; int M, N, K; };
struct StaticOrder {
    int nM, nN, nwg, G, c;
    __host__ __device__ void init(int M, int N, int G_, int c_) { nM = M / BM; nN = N / BM; nwg = nM * nN; G = G_; c = c_; }
    __host__ __device__ bool next(int i, Unit& u) const {
        const long L = (long)i * G + c; if (L >= nwg) return false;
        int wgid = (int)L; { const int q = nwg / NXCD, r = nwg % NXCD, xcd = wgid % NXCD, off = wgid / NXCD; wgid = (xcd < r ? xcd * (q + 1) : r * (q + 1) + (xcd - r) * q) + off; }
        const int nig = WGM * nN, gid = wgid / nig, fm = gid * WGM, gsz = (nM - fm) < WGM ? (nM - fm) : WGM;
        u.pm = fm + ((wgid % nig) % gsz); u.pn = (wgid % nig) / gsz; return true;
    }
    __device__ __forceinline__ void a_ready(const Unit&) const {}
    __device__ __forceinline__ void done(const Unit&) const {}
};

template <class Epi, class Sched>
__device__ __forceinline__ void gemm_phase(PG8_LAS unsigned char* lds, const Gemm g, const Sched& S, const Epi& E) {
    const int tid = threadIdx.x, wid = __builtin_amdgcn_readfirstlane(tid >> 6), lane = tid & 63, wr = wid >> 2, wc = wid & 3, fr = lane & 15, fq = lane >> 4;
    const int K = g.K, nt = K / BK;
    unsigned voffA[2], voffB[2];
#pragma unroll
    for (int i = 0; i < 2; ++i) { int R, C; stage_rc(tid * 16 + i * 8192, R, C); const int Rb = Epi::PERM ? ((R & ~31) + perm32(R & 31)) : R;
        voffA[i] = (unsigned)(R * K + C) * 2u; voffB[i] = (unsigned)(Rb * K + C) * 2u; }
    const size_t kstep = (size_t)(BK * 2);
    const size_t hstep = (size_t)HALF * K * 2;
    const size_t tstep = 2 * hstep;
    const unsigned ldsw = (unsigned)wid * 1024u;
    const int aoff = lds_byte(wr * 64 + fr, fq * 8), boff = lds_byte(wc * 32 + fr, fq * 8);
#define PG8_SA(b, h) (((b) * 2 + (h)) * HTB)
#define PG8_SB(b, h) ((4 + (b) * 2 + (h)) * HTB)
#define PG8_STAGE(bufoff, gbase, voff) do { _Pragma("unroll") for (int _i = 0; _i < 2; ++_i) \
        __builtin_amdgcn_global_load_lds((const unsigned*)((const char*)(gbase) + (voff)[_i]), (PG8_LAS unsigned*)(lds + (bufoff) + ldsw + _i * 8192), 16, 0, 0); } while (0)
#define PG8_LDA(dst, b, h) do { _Pragma("unroll") for (int m = 0; m < 4; ++m) _Pragma("unroll") for (int k = 0; k < 2; ++k) dst[m][k] = *(const PG8_LAS bf16x8*)(lds + PG8_SA(b, h) + aoff + m * 2048 + k * 1024); } while (0)
#define PG8_LDB(dst, b, h) do { _Pragma("unroll") for (int n = 0; n < 2; ++n) _Pragma("unroll") for (int k = 0; k < 2; ++k) dst[n][k] = *(const PG8_LAS bf16x8*)(lds + PG8_SB(b, h) + boff + n * 2048 + k * 1024); } while (0)
#define PG8_MMA(ai, bj, At, Bt) do { __builtin_amdgcn_s_setprio(1); _Pragma("unroll") for (int m = 0; m < 4; ++m) _Pragma("unroll") for (int n = 0; n < 2; ++n) _Pragma("unroll") for (int k = 0; k < 2; ++k) \
        acc[ai][bj][m][n] = __builtin_amdgcn_mfma_f32_16x16x32_bf16(Bt[n][k], At[m][k], acc[ai][bj][m][n], 0, 0, 0); __builtin_amdgcn_s_setprio(0); } while (0)
#define PG8_WAIT_V(n) asm volatile("s_waitcnt vmcnt(" #n ")" ::: "memory")
#define PG8_WAIT_L(n) asm volatile("s_waitcnt lgkmcnt(" #n ")" ::: "memory")
#define PG8_BAR __builtin_amdgcn_s_barrier()
#define PG8_SCHED __builtin_amdgcn_sched_barrier(0)
    Unit cur, nxt; int ui = 0;
    if (!S.next(0, cur)) return;
    f32x4 acc[2][2][4][2];
#pragma unroll
    for (int a = 0; a < 2; ++a)
#pragma unroll
        for (int b = 0; b < 2; ++b)
#pragma unroll
            for (int m = 0; m < 4; ++m)
#pragma unroll
                for (int n = 0; n < 2; ++n) acc[a][b][m][n] = (f32x4){0.f, 0.f, 0.f, 0.f};
    bf16x8 At[4][2], B0[2][2], B1[2][2];
    const char* cA = (const char*)g.A + (size_t)cur.pm * tstep; const char* cB = (const char*)g.Bt + (size_t)cur.pn * tstep;
    S.a_ready(cur);
    PG8_STAGE(PG8_SB(0, 0), cB, voffB); PG8_STAGE(PG8_SA(0, 0), cA, voffA); PG8_STAGE(PG8_SB(0, 1), cB + hstep, voffB); PG8_STAGE(PG8_SA(0, 1), cA + hstep, voffA);
    if (wr == 1) PG8_BAR;
    PG8_WAIT_V(4); PG8_BAR;
    PG8_STAGE(PG8_SB(1, 0), cB + kstep, voffB); PG8_STAGE(PG8_SA(1, 0), cA + kstep, voffA); PG8_STAGE(PG8_SB(1, 1), cB + hstep + kstep, voffB);
    PG8_WAIT_V(6); PG8_BAR;
    for (;;) {
        const bool has_next = S.next(ui + 1, nxt);
        const char* nA = has_next ? (const char*)g.A + (size_t)nxt.pm * tstep : cA; const char* nB = has_next ? (const char*)g.Bt + (size_t)nxt.pn * tstep : cB;
        for (int t = 0; t < nt; t += 2) {
            const bool last = (t == nt - 2);
            const char* a1 = cA + (size_t)(t + 1) * kstep;
            const char* a2 = last ? nA : cA + (size_t)(t + 2) * kstep; const char* b2 = last ? nB : cB + (size_t)(t + 2) * kstep;
            const char* a3 = a2 + kstep; const char* b3 = b2 + kstep;
            if (last && has_next) S.a_ready(nxt);
            PG8_LDB(B0, 0, 0); PG8_SCHED; PG8_LDA(At, 0, 0); PG8_STAGE(PG8_SA(1, 1), a1 + hstep, voffA);
            PG8_WAIT_L(8); PG8_BAR; PG8_WAIT_L(0); PG8_MMA(0, 0, At, B0); PG8_BAR; PG8_SCHED;
            PG8_LDB(B1, 0, 1); PG8_STAGE(PG8_SB(0, 0), b2, voffB);
            PG8_BAR; PG8_WAIT_L(0); PG8_MMA(0, 1, At, B1); PG8_BAR;
            PG8_LDA(At, 0, 1); PG8_STAGE(PG8_SA(0, 0), a2, voffA);
            PG8_BAR; PG8_WAIT_L(0); PG8_MMA(1, 0, At, B0); PG8_BAR; PG8_SCHED;
            PG8_STAGE(PG8_SB(0, 1), b2 + hstep, voffB);
            PG8_WAIT_V(6); PG8_BAR; PG8_MMA(1, 1, At, B1); PG8_BAR;
            PG8_LDB(B0, 1, 0); PG8_SCHED; PG8_LDA(At, 1, 0); PG8_STAGE(PG8_SA(0, 1), a2 + hstep, voffA);
            PG8_WAIT_L(8); PG8_BAR; PG8_WAIT_L(0); PG8_MMA(0, 0, At, B0); PG8_BAR; PG8_SCHED;
            PG8_LDB(B1, 1, 1); PG8_STAGE(PG8_SB(1, 0), b3, voffB);
            PG8_BAR; PG8_WAIT_L(0); PG8_MMA(0, 1, At, B1); PG8_BAR;
            PG8_LDA(At, 1, 1); PG8_STAGE(PG8_SA(1, 0), a3, voffA);
            PG8_BAR; PG8_WAIT_L(0); PG8_MMA(1, 0, At, B0); PG8_BAR; PG8_SCHED;
            PG8_STAGE(PG8_SB(1, 1), b3 + hstep, voffB);
            PG8_WAIT_V(6); PG8_BAR; PG8_MMA(1, 1, At, B1); PG8_BAR;
        }
        E(acc, cur, wr, wc, fr, fq); S.done(cur);
        if (!has_next) break;
#pragma unroll
        for (int a = 0; a < 2; ++a)
#pragma unroll
            for (int b = 0; b < 2; ++b)
#pragma unroll
                for (int m = 0; m < 4; ++m)
#pragma unroll
                    for (int n = 0; n < 2; ++n) acc[a][b][m][n] = (f32x4){0.f, 0.f, 0.f, 0.f};
        cur = nxt; cA = nA; cB = nB; ++ui;
    }
    PG8_WAIT_V(0);
    if (wr == 0) PG8_BAR;
    PG8_BAR;
#undef PG8_SA
#undef PG8_SB
#undef PG8_STAGE
#undef PG8_LDA
#undef PG8_LDB
#undef PG8_MMA
#undef PG8_WAIT_V
#undef PG8_WAIT_L
#undef PG8_BAR
#undef PG8_SCHED
}
}

typedef f32x4 AccT[2][2][4][2];

struct EpiIn {
    static constexpr bool PERM = true;
    unsigned short* G; bf16_t* V; bf16_t* Q; bf16_t* GATE; bf16_t* BG; bf16_t* P; const float* lb;
    __device__ __forceinline__ void operator()(const AccT& acc, const pg8::Unit& u, int wr, int wc, int fr, int fq) const {
        const int row0 = u.pm * 256 + wr * 64 + fr, cl = wc * 32 + 8 * fq, pn = u.pn;
        if (pn < 8) {
#pragma unroll
            for (int bj = 0; bj < 2; ++bj) {
                const int col = pn * 256 + bj * 128 + cl;
                const f32x4 l0 = *(const f32x4*)(lb + col), l1 = *(const f32x4*)(lb + col + 4);
#pragma unroll
                for (int ai = 0; ai < 2; ++ai)
#pragma unroll
                    for (int m = 0; m < 4; ++m) {
                        const f32x4 a = acc[ai][bj][m][0], b = acc[ai][bj][m][1]; float g[8];
#pragma unroll
                        for (int j = 0; j < 4; ++j) { g[j] = (1.f - l0[j]) * __builtin_amdgcn_rcpf(1.f + __expf(a[j])); g[4 + j] = (1.f - l1[j]) * __builtin_amdgcn_rcpf(1.f + __expf(b[j])); }
                        u32x4 w; w.x = pk_h2(g[0], g[1]); w.y = pk_h2(g[2], g[3]); w.z = pk_h2(g[4], g[5]); w.w = pk_h2(g[6], g[7]);
                        *(u32x4*)(G + (size_t)(row0 + ai * 128 + m * 16) * 2048 + col) = w;
                    }
            }
        } else if (pn < 24) {
            if (u.pm >= 128 && pn >= 12) return;
            const int ty = (pn - 8) >> 2; bf16_t* base = V + (ty == 0 ? (size_t)0 : (size_t)TALL * HW + (size_t)(ty - 1) * T * HW);
            const bool act = (ty == 1);
            const int colt = (pn - 8 - 4 * ty) * 256;
#pragma unroll
            for (int ai = 0; ai < 2; ++ai)
#pragma unroll
                for (int m = 0; m < 4; ++m)
#pragma unroll
                    for (int bj = 0; bj < 2; ++bj) {
                        f32x4 a = acc[ai][bj][m][0], b = acc[ai][bj][m][1];
                        if (act) {
#pragma unroll
                            for (int j = 0; j < 4; ++j) { a[j] = silu_f(a[j]); b[j] = silu_f(b[j]); } }
                        u32x4 w; w.x = cvt_pk_bf16(a[0], a[1]); w.y = cvt_pk_bf16(a[2], a[3]); w.z = cvt_pk_bf16(b[0], b[1]); w.w = cvt_pk_bf16(b[2], b[3]);
                        *(u32x4*)(base + (size_t)(row0 + ai * 128 + m * 16) * 1024 + colt + bj * 128 + cl) = w;
                    }
        } else {
            if (u.pm >= 128) return;
            const int col = (pn - 24) * 128 + cl;
#pragma unroll
            for (int ai = 0; ai < 2; ++ai)
#pragma unroll
                for (int m = 0; m < 4; ++m) {
                    const f32x4 a = acc[ai][0][m][0] * acc[ai][1][m][0], b = acc[ai][0][m][1] * acc[ai][1][m][1];
                    u32x4 w; w.x = cvt_pk_bf16(a[0], a[1]); w.y = cvt_pk_bf16(a[2], a[3]); w.z = cvt_pk_bf16(b[0], b[1]); w.w = cvt_pk_bf16(b[2], b[3]);
                    *(u32x4*)(P + (size_t)(row0 + ai * 128 + m * 16) * 1024 + col) = w;
                }
        }
    }
};
struct EpiOut {
    static constexpr bool PERM = true;
    const float* x; const float* mod; unsigned short* U1;
    __device__ __forceinline__ void operator()(const AccT& acc, const pg8::Unit& u, int wr, int wc, int fr, int fq) const {
        const int row0 = u.pm * 256 + wr * 64 + fr, col0 = u.pn * 256 + wc * 32 + 8 * fq;
        const float* ga = mod + (u.pm >= 64 ? 12288 : 0) + 2 * 2048;
        f32x4 gv[2][2];
#pragma unroll
        for (int bj = 0; bj < 2; ++bj)
#pragma unroll
            for (int n = 0; n < 2; ++n) gv[bj][n] = *(const f32x4*)(ga + col0 + bj * 128 + n * 4);
#pragma unroll
        for (int ai = 0; ai < 2; ++ai) {
            f32x4 xa[4][2], xb[4][2];
#pragma unroll
            for (int m = 0; m < 4; ++m) { const size_t off = (size_t)(row0 + ai * 128 + m * 16) * D + col0;
#pragma unroll
                for (int bj = 0; bj < 2; ++bj) { xa[m][bj] = *(const f32x4*)(x + off + bj * 128); xb[m][bj] = *(const f32x4*)(x + off + bj * 128 + 4); } }
#pragma unroll
            for (int m = 0; m < 4; ++m) { const size_t off = (size_t)(row0 + ai * 128 + m * 16) * D + col0;
#pragma unroll
                for (int bj = 0; bj < 2; ++bj) {
                    const f32x4 a = ALPHA * xa[m][bj] + gv[bj][0] * acc[ai][bj][m][0], b = ALPHA * xb[m][bj] + gv[bj][1] * acc[ai][bj][m][1];
                    u32x4 w; w.x = pk_h2(a[0], a[1]); w.y = pk_h2(a[2], a[3]); w.z = pk_h2(b[0], b[1]); w.w = pk_h2(b[2], b[3]);
                    *(u32x4*)(U1 + off + bj * 128) = w; } }
        }
    }
};
struct EpiGU {
    static constexpr bool PERM = true;
    bf16_t* HID;
    __device__ __forceinline__ void operator()(const AccT& acc, const pg8::Unit& u, int wr, int wc, int fr, int fq) const {
        const int row0 = u.pm * 256 + wr * 64 + fr, col = u.pn * 128 + wc * 32 + 8 * fq;
#pragma unroll
        for (int ai = 0; ai < 2; ++ai)
#pragma unroll
            for (int m = 0; m < 4; ++m) {
                f32x4 a = acc[ai][0][m][0], b = acc[ai][0][m][1];
#pragma unroll
                for (int j = 0; j < 4; ++j) { a[j] = silu_f(a[j]) * acc[ai][1][m][0][j]; b[j] = silu_f(b[j]) * acc[ai][1][m][1][j]; }
                u32x4 w; w.x = cvt_pk_bf16(a[0], a[1]); w.y = cvt_pk_bf16(a[2], a[3]); w.z = cvt_pk_bf16(b[0], b[1]); w.w = cvt_pk_bf16(b[2], b[3]);
                *(u32x4*)(HID + (size_t)(row0 + ai * 128 + m * 16) * DFF + col) = w;
            }
    }
};
struct EpiDown {
    static constexpr bool PERM = true;
    const unsigned short* U1; const float* stats; const float* mod; const float* g1; const float* b1; unsigned short* U2;
    __device__ __forceinline__ void operator()(const AccT& acc, const pg8::Unit& u, int wr, int wc, int fr, int fq) const {
        const int row0 = u.pm * 256 + wr * 64 + fr, col0 = u.pn * 256 + wc * 32 + 8 * fq;
        const float* ga = mod + (u.pm >= 64 ? 12288 : 0) + 5 * 2048;
        f32x4 gv[2][2], lg[2][2], lbv[2][2];
#pragma unroll
        for (int bj = 0; bj < 2; ++bj)
#pragma unroll
            for (int n = 0; n < 2; ++n) { const int c = col0 + bj * 128 + n * 4; gv[bj][n] = *(const f32x4*)(ga + c); lg[bj][n] = ALPHA * *(const f32x4*)(g1 + c); lbv[bj][n] = ALPHA * *(const f32x4*)(b1 + c); }
#pragma unroll
        for (int ai = 0; ai < 2; ++ai) {
            u32x4 uraw[4][2]; f32x2 stv[4];
#pragma unroll
            for (int m = 0; m < 4; ++m) { const int row = row0 + ai * 128 + m * 16; const size_t off = (size_t)row * D + col0; stv[m] = *(const f32x2*)(stats + 2 * row);
#pragma unroll
                for (int bj = 0; bj < 2; ++bj) uraw[m][bj] = *(const u32x4*)(U1 + off + bj * 128); }
#pragma unroll
            for (int m = 0; m < 4; ++m) { const int row = row0 + ai * 128 + m * 16; const size_t off = (size_t)row * D + col0; const f32x2 st = stv[m];
#pragma unroll
                for (int bj = 0; bj < 2; ++bj) { float uf[8]; unpack_h8(uraw[m][bj], uf);
                    const f32x4 ua = {uf[0], uf[1], uf[2], uf[3]}, ub = {uf[4], uf[5], uf[6], uf[7]};
                    const f32x4 a = ((ua - st.x) * st.y) * lg[bj][0] + lbv[bj][0] + gv[bj][0] * acc[ai][bj][m][0], b = ((ub - st.x) * st.y) * lg[bj][1] + lbv[bj][1] + gv[bj][1] * acc[ai][bj][m][1];
                    u32x4 w; w.x = pk_h2(a[0], a[1]); w.y = pk_h2(a[2], a[3]); w.z = pk_h2(b[0], b[1]); w.w = pk_h2(b[2], b[3]);
                    *(u32x4*)(U2 + off + bj * 128) = w; } }
        }
    }
};
#define XB_TMO      128
#define XB_XCNT(j)  (256  + 64 * (j))
#define XB_XSUB(j)  (1280 + 64 * (j))
#define XB_XGEN(j)  (2304 + 64 * (j))
#define XB_TOP      3328
#define XB_TOPGEN   3392
#define XCD_BAR_WORDS 3456
#define XB_SPIN_CAP (1u << 18)
__device__ __forceinline__ unsigned xb_ld(unsigned* p)              { return __hip_atomic_load(p, __ATOMIC_RELAXED, __HIP_MEMORY_SCOPE_AGENT); }
__device__ __forceinline__ unsigned xb_add(unsigned* p, unsigned v) { return __hip_atomic_fetch_add(p, v, __ATOMIC_RELAXED, __HIP_MEMORY_SCOPE_AGENT); }
__device__ __forceinline__ unsigned xb_xcc_id() { return (unsigned)__builtin_amdgcn_s_getreg((3 << 11) | 20) & 0xFu; }
#define XB_SPIN(cond, bar) do { unsigned _sp = 0; while (cond) { __builtin_amdgcn_s_sleep(1); \
    if ((++_sp & 255u) == 0u) { if (xb_ld(&(bar)[XB_TMO])) break; if (_sp > XB_SPIN_CAP) { atomicAdd(&(bar)[XB_TMO], 1u); break; } } } } while (0)
struct XcdBarrier { unsigned* bar; unsigned x; volatile PG8_LAS unsigned* st; };
__device__ __forceinline__ XcdBarrier xcd_barrier_post(unsigned* bar, volatile PG8_LAS unsigned* st) {
    XcdBarrier b; b.bar = bar; b.x = xb_xcc_id(); b.st = st;
    if (threadIdx.x == 0) (void)xb_add(&bar[XB_XCNT(b.x)], 1u);
    return b;
}
__device__ __forceinline__ void xcd_barrier_complete(unsigned* bar, unsigned x, unsigned& nloc, unsigned& nx) {
    const unsigned G = gridDim.x * gridDim.y * gridDim.z;
    unsigned sum, cnt, mine, sp = 0u;
    for (;;) {
        sum = 0u; cnt = 0u; mine = 0u;
#pragma unroll
        for (unsigned j = 0; j < 16; ++j) { const unsigned c = xb_ld(&bar[XB_XCNT(j)]); sum += c; cnt += (c > 0u) ? 1u : 0u; mine = (j == x) ? c : mine; }
        if (sum == G) break;
        __builtin_amdgcn_s_sleep(1);
        if ((++sp & 255u) == 0u) { if (xb_ld(&bar[XB_TMO])) break; if (sp > XB_SPIN_CAP) { atomicAdd(&bar[XB_TMO], 1u); break; } }
    }
    nloc = mine > 0u ? mine : 1u; nx = cnt > 0u ? cnt : 1u;
}
__device__ __forceinline__ void xcd_barrier(const XcdBarrier& b) {
    asm volatile("s_waitcnt vmcnt(0)" ::: "memory");
    __syncthreads();
    if (threadIdx.x == 0) {
        unsigned* bar = b.bar;
        __builtin_amdgcn_s_waitcnt(0);
        unsigned nloc = b.st[0], nx = b.st[1];
        if (nloc == 0u) { xcd_barrier_complete(bar, b.x, nloc, nx); b.st[0] = nloc; b.st[1] = nx; }
        const unsigned old = xb_add(&bar[XB_XSUB(b.x)], 1u);
        const unsigned gen = old / nloc;
        if (old + 1u == (gen + 1u) * nloc) {
            __builtin_amdgcn_fence(__ATOMIC_RELEASE, "agent");
            asm volatile("s_waitcnt vmcnt(0)" ::: "memory");
            const unsigned og = xb_add(&bar[XB_TOP], 1u);
            const unsigned tg = og / nx;
            if (og + 1u == (tg + 1u) * nx) xb_add(&bar[XB_TOPGEN], 1u);
            else XB_SPIN(xb_ld(&bar[XB_TOPGEN]) == tg, bar);
            __builtin_amdgcn_fence(__ATOMIC_ACQUIRE, "agent");
            xb_add(&bar[XB_XGEN(b.x)], 1u);
            asm volatile("s_waitcnt vmcnt(0)" ::: "memory");
        } else {
            XB_SPIN(xb_ld(&bar[XB_XGEN(b.x)]) == gen, bar);
            __builtin_amdgcn_fence(__ATOMIC_ACQUIRE, "agent");
            asm volatile("s_waitcnt vmcnt(0)" ::: "memory");
        }
    }
    __syncthreads();
}

struct OneUnit {
    int pm, pn;
    __device__ __forceinline__ bool next(int i, pg8::Unit& u) const { if (i != 0) return false; u.pm = pm; u.pn = pn; return true; }
    __device__ __forceinline__ void a_ready(const pg8::Unit&) const {}
    __device__ __forceinline__ void done(const pg8::Unit&) const {}
};

struct Params {
    const float *x, *c, *ctx, *cctx, *w_mod, *b_mod, *w_in, *lb_logits, *g_norm_w, *conv_w, *w_out, *ln1_g, *ln1_b, *w_gate, *w_up, *w_down, *ln2_g, *ln2_b;
    float* out; unsigned char* ws; int lo, hi;
};

__device__ __forceinline__ void transpose_item(const float* W, int N, bf16_t* WT, int K, int k0, int n0, int dest_row0, float*  , int lane) {
    typedef unsigned u32x2s __attribute__((ext_vector_type(2)));
    float tv[32];
#pragma unroll
    for (int i = 0; i < 32; ++i) tv[i] = W[(size_t)(k0 + 2 * i + (lane >> 5)) * N + n0 + (lane & 31)];
    unsigned pk[16];
#pragma unroll
    for (int i = 0; i < 16; ++i) {
        const u32x2s r = __builtin_amdgcn_permlane32_swap(__float_as_uint(tv[i]), __float_as_uint(tv[i + 16]), false, false);
        pk[i] = cvt_pk_bf16(__uint_as_float(r.x), __uint_as_float(r.y));
    }
    bf16_t* dst = WT + (size_t)(dest_row0 + (lane & 31)) * K + k0 + (lane >> 5) * 32;
#pragma unroll
    for (int j = 0; j < 4; ++j) *(u32x4*)(dst + 8 * j) = (u32x4){pk[4 * j], pk[4 * j + 1], pk[4 * j + 2], pk[4 * j + 3]};
}

__device__ __forceinline__ void phase_prep(const Params& p, unsigned char* lds) {
    const int tid = threadIdx.x, lane = tid & 63, wave = tid >> 6;
    float* modv = (float*)(p.ws + WS_MOD);
    {
        float* sc = (float*)lds;
        float* red = (float*)(lds + 24576);
        for (int i = tid; i < 3 * 2048; i += 512) { const int o = i >> 11, k = i & 2047; const float v = o == 0 ? p.c[k] : o == 1 ? p.c[2048 + k] : p.cctx[k]; sc[i] = silu_f(v); }
        __syncthreads();
        for (int item = blockIdx.x; item < 256; item += gridDim.x) {
            const int col0 = item * 48, kq = tid / 12, c4 = tid % 12;
            f32x4 a0 = {0, 0, 0, 0}, a1 = {0, 0, 0, 0}, a2 = {0, 0, 0, 0};
            if (kq < 42) {
#pragma unroll 7
                for (int k = kq; k < 2048; k += 42) {
                    const f32x4 w = *(const f32x4*)(p.w_mod + (size_t)k * 12288 + col0 + 4 * c4);
                    a0 += sc[k] * w; a1 += sc[2048 + k] * w; a2 += sc[4096 + k] * w;
                }
                float* r = red + (kq * 12 + c4) * 12;
                *(f32x4*)(r) = a0; *(f32x4*)(r + 4) = a1; *(f32x4*)(r + 8) = a2;
            }
            __syncthreads();
            if (tid < 144) { const int o = tid / 48, cc = tid % 48; float s = 0.f;
                for (int q = 0; q < 42; ++q) s += red[(q * 12 + (cc >> 2)) * 12 + o * 4 + (cc & 3)];
                modv[o * 12288 + col0 + cc] = s + p.b_mod[col0 + cc]; }
            __syncthreads();
        }
    }
    if (blockIdx.x < 4) { const int idx = blockIdx.x * 512 + tid, dir = idx >> 10, ch = idx & 1023;
        const float a0 = p.lb_logits[dir * 2048 + ch], a1 = p.lb_logits[dir * 2048 + 1024 + ch];
        ((float*)(p.ws + WS_LB))[idx] = 1.f / (1.f + __expf(a1 - a0)); }
    {
        const int gw = blockIdx.x * 8 + wave, NGW = gridDim.x * 8;
        constexpr int I_IN = 32 * 256, I_OUT = 32 * 64, I_G = 32 * 176, I_D = 88 * 64;
        constexpr int NITEMS = I_IN + I_OUT + 2 * I_G + I_D;
        bf16_t* Win = (bf16_t*)(p.ws + WS_WIN); bf16_t* Wout = (bf16_t*)(p.ws + WS_WOUT); bf16_t* Wgu = (bf16_t*)(p.ws + WS_WGU); bf16_t* Wdn = (bf16_t*)(p.ws + WS_WDN);
        typedef unsigned u32x2s __attribute__((ext_vector_type(2)));
        for (int it0 = gw; it0 < NITEMS; it0 += 2 * NGW) {
            const float* src[2]; bf16_t* dstp[2]; int srcN[2]; bool valid[2];
#pragma unroll
            for (int u = 0; u < 2; ++u) {
                int r = it0 + u * NGW; valid[u] = r < NITEMS; if (!valid[u]) r = it0;
                const float* W; int N, K, k0, n0, drow; bf16_t* WT;
                if (r < I_IN) { const int kb = r / 256, nb = r % 256; n0 = nb * 32; drow = n0;
                    if (n0 >= 6144) { const int isx = n0 >= 7168, j = n0 - (isx ? 7168 : 6144); drow = 6144 + 256 * (j >> 7) + 128 * isx + (j & 127); }
                    W = p.w_in; N = NIN; WT = Win; K = D; k0 = kb * 64; }
                else if (r < I_IN + I_OUT) { r -= I_IN; const int kb = r / 64, nb = r % 64; W = p.w_out; N = D; WT = Wout; K = D; k0 = kb * 64; n0 = nb * 32; drow = n0; }
                else if (r < I_IN + I_OUT + I_G) { r -= I_IN + I_OUT; const int kb = r / 176, nb = r % 176; n0 = nb * 32; W = p.w_gate; N = DFF; WT = Wgu; K = D; k0 = kb * 64; drow = 256 * (n0 >> 7) + (n0 & 127); }
                else if (r < I_IN + I_OUT + 2 * I_G) { r -= I_IN + I_OUT + I_G; const int kb = r / 176, nb = r % 176; n0 = nb * 32; W = p.w_up; N = DFF; WT = Wgu; K = D; k0 = kb * 64; drow = 256 * (n0 >> 7) + 128 + (n0 & 127); }
                else { r -= I_IN + I_OUT + 2 * I_G; const int kb = r / 64, nb = r % 64; W = p.w_down; N = D; WT = Wdn; K = DFF; k0 = kb * 64; n0 = nb * 32; drow = n0; }
                src[u] = W + (size_t)(k0 + (lane >> 5)) * N + n0 + (lane & 31); srcN[u] = N;
                dstp[u] = WT + (size_t)(drow + (lane & 31)) * K + k0 + (lane >> 5) * 32;
            }
            float tv[2][32];
#pragma unroll
            for (int u = 0; u < 2; ++u)
#pragma unroll
                for (int i = 0; i < 32; ++i) tv[u][i] = src[u][(size_t)(2 * i) * srcN[u]];
#pragma unroll
            for (int u = 0; u < 2; ++u) {
                if (!valid[u]) break;
                unsigned pk[16];
#pragma unroll
                for (int i = 0; i < 16; ++i) { const u32x2s rr = __builtin_amdgcn_permlane32_swap(__float_as_uint(tv[u][i]), __float_as_uint(tv[u][i + 16]), false, false);
                    pk[i] = cvt_pk_bf16(__uint_as_float(rr.x), __uint_as_float(rr.y)); }
#pragma unroll
                for (int j = 0; j < 4; ++j) *(u32x4*)(dstp[u] + 8 * j) = (u32x4){pk[4 * j], pk[4 * j + 1], pk[4 * j + 2], pk[4 * j + 3]};
            }
        }
    }
}

__device__ __forceinline__ void ln_ctx_rows(const Params& p, int row_lo, int nrows) {
    const int lane = threadIdx.x & 63, wave = threadIdx.x >> 6;
    const float* mv = (const float*)(p.ws + WS_MOD) + 24576; bf16_t* H = (bf16_t*)(p.ws + WS_H);
    for (int r0 = 4 * wave; r0 < nrows; r0 += 32) {
        f32x4 v[4][8]; float rstd[4];
#pragma unroll
        for (int r = 0; r < 4; ++r) { const f32x4* xr = (const f32x4*)(p.ctx + (size_t)(row_lo - T + r0 + r) * D) + lane;
#pragma unroll
            for (int j = 0; j < 8; ++j) v[r][j] = xr[64 * j]; }
#pragma unroll
        for (int r = 0; r < 4; ++r) { float s = 0.f;
#pragma unroll
            for (int j = 0; j < 8; ++j) s += (v[r][j].x + v[r][j].y) + (v[r][j].z + v[r][j].w);
            const float mean = wave_sum(s) * (1.f / D); float s2 = 0.f;
#pragma unroll
            for (int j = 0; j < 8; ++j) { v[r][j] = v[r][j] - mean; s2 += (v[r][j].x * v[r][j].x + v[r][j].y * v[r][j].y) + (v[r][j].z * v[r][j].z + v[r][j].w * v[r][j].w); }
            rstd[r] = 1.f / sqrtf(wave_sum(s2) * (1.f / D) + LN_EPS); }
#pragma unroll
        for (int r = 0; r < 4; ++r) { u32x2* o8 = (u32x2*)(H + (size_t)(row_lo + r0 + r) * D) + lane;
#pragma unroll
            for (int j = 0; j < 8; ++j) { const f32x4 sh = *((const f32x4*)mv + lane + 64 * j), sc = *((const f32x4*)(mv + 2048) + lane + 64 * j);
                const f32x4 h = (v[r][j] * rstd[r]) * (1.f + sc) + sh; u32x2 w; w.x = cvt_pk_bf16(h.x, h.y); w.y = cvt_pk_bf16(h.z, h.w); o8[64 * j] = w; } }
    }
}
__device__ __forceinline__ void phase_ln_in(const Params& p, int row_lo, int row_hi, int gw, int NGW) {
    const int lane = threadIdx.x & 63;
    const float* modv = (const float*)(p.ws + WS_MOD); bf16_t* H = (bf16_t*)(p.ws + WS_H);
    f32x4 SHv[8], SCv[8]; int curm = -1;
#pragma unroll
    for (int j = 0; j < 8; ++j) { SHv[j] = (f32x4){0.f, 0.f, 0.f, 0.f}; SCv[j] = SHv[j]; }
    for (int rowa = row_lo + gw; rowa < row_hi; rowa += 2 * NGW) {
      const int rowb = (rowa + NGW < row_hi) ? rowa + NGW : rowa;
      f32x4 va[8], vb[8];
#pragma unroll
      for (int j = 0; j < 8; ++j) { va[j] = __builtin_nontemporal_load((const f32x4*)(rowa < T ? p.x + (size_t)rowa * D : p.ctx + (size_t)(rowa - T) * D) + lane + 64 * j);
                                    vb[j] = __builtin_nontemporal_load((const f32x4*)(rowb < T ? p.x + (size_t)rowb * D : p.ctx + (size_t)(rowb - T) * D) + lane + 64 * j); }
#pragma unroll
      for (int r = 0; r < 2; ++r) {
        if (r == 1 && rowb == rowa) break;
        const int row = r == 0 ? rowa : rowb;
        const int mrow = row < SEQ ? 0 : row < T ? 1 : 2;
        if (mrow != curm) { curm = mrow; const float* mv = modv + mrow * 12288;
#pragma unroll
            for (int j = 0; j < 8; ++j) { SHv[j] = *((const f32x4*)mv + lane + 64 * j); SCv[j] = 1.f + *((const f32x4*)(mv + 2048) + lane + 64 * j); } }
        f32x4 v[8]; float s = 0.f;
#pragma unroll
        for (int j = 0; j < 8; ++j) { v[j] = r == 0 ? va[j] : vb[j]; s += (v[j].x + v[j].y) + (v[j].z + v[j].w); }
        const float mean = wave_sum(s) * (1.f / D); float s2 = 0.f;
#pragma unroll
        for (int j = 0; j < 8; ++j) { v[j] = v[j] - mean; s2 += (v[j].x * v[j].x + v[j].y * v[j].y) + (v[j].z * v[j].z + v[j].w * v[j].w); }
        const float rstd = 1.f / sqrtf(wave_sum(s2) * (1.f / D) + LN_EPS);
        u32x2* o8 = (u32x2*)(H + (size_t)row * D) + lane;
#pragma unroll
        for (int j = 0; j < 8; ++j) { const f32x4 h = (v[j] * rstd) * SCv[j] + SHv[j]; u32x2 w; w.x = cvt_pk_bf16(h.x, h.y); w.y = cvt_pk_bf16(h.z, h.w); o8[64 * j] = w; }
      }
    }
}

constexpr int L_QH = 0, L_KH = 17408, L_KHT = 34816, L_VT = 53248, L_SC = 71680, L_PART = 80896, L_ER = 84992, L_EBR = 85504;
#define MFMA16(a, b, c) __builtin_amdgcn_mfma_f32_16x16x32_bf16(a, b, c, 0, 0, 0)

#define SCAN_LOADB(GK, VV, QQ, c) do { _Pragma("unroll") for (int j = 0; j < 8; ++j) { const size_t row = (size_t)(r0 + rs * (64 * (c) + 8 * w + j)); \
        GK[j] = *(const unsigned*)(Gp + row * 2048 + gcol + 2 * lane); VV[j] = *(const unsigned*)(Vp + row * 1024 + hcol + 2 * lane); if (OUT) QQ[j] = *(const unsigned*)(Qp + row * 1024 + hcol + 2 * lane); } } while (0)
#define SCAN_BAR() do { asm volatile("s_waitcnt lgkmcnt(0)" ::: "memory"); __builtin_amdgcn_s_barrier(); asm volatile("" ::: "memory"); } while (0)
template <bool OUT>
__device__ __forceinline__ void scan_chunk(unsigned char* lds, const unsigned short* Gp, const bf16_t* Vp, const bf16_t* Qp, bf16_t* Op, int r0, int rs, int c, int cpre, int gcol, int hcol,
                                           f32x4 (&S)[8], f32x2& dtot, unsigned (&gk)[8], unsigned (&vv)[8], unsigned (&qq)[8]) {
    const int tid = threadIdx.x, lane = tid & 63, w = __builtin_amdgcn_readfirstlane(tid >> 6), fr = lane & 15, q = lane >> 4;
    float* PART = (float*)(lds + L_PART); float* ER = (float*)(lds + L_ER); float* EBR = (float*)(lds + L_EBR);
    {
        f32x2 kf[8], loc[8]; f32x2 run = {1.f, 1.f};
#pragma unroll
        for (int j = 0; j < 8; ++j) { const h16x2 kk = __builtin_bit_cast(h16x2, gk[j]); kf[j] = (f32x2){(float)kk.x, (float)kk.y}; }
        if (w >= 4) {
#pragma unroll
            for (int j = 0; j < 8; ++j) { run *= 1.f - kf[j]; loc[j] = run; }
        } else {
#pragma unroll
            for (int j = 7; j >= 0; --j) { loc[j] = run; run *= 1.f - kf[j]; }
        }
        *(f32x2*)(PART + w * 128 + 2 * lane) = run;
        SCAN_BAR();
        {
            f32x2 pv[8];
#pragma unroll
            for (int o = 0; o < 8; ++o) pv[o] = *(const f32x2*)(PART + o * 128 + 2 * lane);
            f32x2 fac = {1.f, 1.f};
#pragma unroll
            for (int o = 0; o < 8; ++o) { const bool use = (w >= 4) ? (o >= 4 && o < w) : (o > w && o <= 3); if (use) fac *= pv[o]; }
            f32x2 kh[8];
#pragma unroll
            for (int j = 0; j < 8; ++j) {
                const f32x2 m = loc[j] * fac; const f32x2 inv = {__builtin_amdgcn_rcpf(m.x), __builtin_amdgcn_rcpf(m.y)};
                kh[j] = kf[j] * (w >= 4 ? inv : m);
                if (OUT) {
                    const f32x2 e1 = w >= 4 ? m : inv;
                    const unsigned qp = cvt_pk_bf16(__uint_as_float(qq[j] << 16) * e1.x, __uint_as_float(qq[j] & 0xffff0000u) * e1.y);
                    const int i = 8 * w + j;
                    *(unsigned*)(lds + L_QH + i * 272 + 4 * lane) = qp;
                    *(unsigned*)(lds + L_KH + i * 272 + 4 * lane) = cvt_pk_bf16(kh[j].x, kh[j].y);
                }
            }
            *(u32x4*)(lds + L_KHT + (2 * lane) * 144 + 16 * w) = (u32x4){cvt_pk_bf16(kh[0].x, kh[1].x), cvt_pk_bf16(kh[2].x, kh[3].x), cvt_pk_bf16(kh[4].x, kh[5].x), cvt_pk_bf16(kh[6].x, kh[7].x)};
            *(u32x4*)(lds + L_KHT + (2 * lane + 1) * 144 + 16 * w) = (u32x4){cvt_pk_bf16(kh[0].y, kh[1].y), cvt_pk_bf16(kh[2].y, kh[3].y), cvt_pk_bf16(kh[4].y, kh[5].y), cvt_pk_bf16(kh[6].y, kh[7].y)};
            *(u32x4*)(lds + L_VT + (2 * lane) * 144 + 16 * w) = (u32x4){__builtin_amdgcn_perm(vv[1], vv[0], 0x05040100u), __builtin_amdgcn_perm(vv[3], vv[2], 0x05040100u), __builtin_amdgcn_perm(vv[5], vv[4], 0x05040100u), __builtin_amdgcn_perm(vv[7], vv[6], 0x05040100u)};
            *(u32x4*)(lds + L_VT + (2 * lane + 1) * 144 + 16 * w) = (u32x4){__builtin_amdgcn_perm(vv[1], vv[0], 0x07060302u), __builtin_amdgcn_perm(vv[3], vv[2], 0x07060302u), __builtin_amdgcn_perm(vv[5], vv[4], 0x07060302u), __builtin_amdgcn_perm(vv[7], vv[6], 0x07060302u)};
            if (w == 0) { const f32x2 er = (pv[0] * pv[1]) * (pv[2] * pv[3]), ebr = (pv[4] * pv[5]) * (pv[6] * pv[7]); *(f32x2*)(ER + 2 * lane) = er; *(f32x2*)(EBR + 2 * lane) = ebr;
                dtot += (f32x2){__logf(er.x) + __logf(ebr.x), __logf(er.y) + __logf(ebr.y)}; }
        }
        if (cpre >= 0) SCAN_LOADB(gk, vv, qq, cpre);
        SCAN_BAR();
#pragma unroll
        for (int kt = 0; kt < 8; ++kt) S[kt] *= *(const f32x4*)(ER + 16 * kt + 4 * q);
        f32x4 oacc[4];
        if (OUT) {
            bf16x8 Sb[4];
#pragma unroll
            for (int m = 0; m < 4; ++m) { u32x4 t; t.x = cvt_pk_bf16(S[2 * m][0], S[2 * m][1]); t.y = cvt_pk_bf16(S[2 * m][2], S[2 * m][3]); t.z = cvt_pk_bf16(S[2 * m + 1][0], S[2 * m + 1][1]); t.w = cvt_pk_bf16(S[2 * m + 1][2], S[2 * m + 1][3]);
                Sb[m] = __builtin_bit_cast(bf16x8, t); }
#pragma unroll
            for (int tb = 0; tb < 4; ++tb) { oacc[tb] = (f32x4){0.f, 0.f, 0.f, 0.f};
#pragma unroll
                for (int m = 0; m < 4; ++m) { const unsigned char* qa = lds + L_QH + (16 * tb + fr) * 272 + (32 * m + 4 * q) * 2;
                    const u32x2 lo = *(const u32x2*)qa, hi = *(const u32x2*)(qa + 32);
                    const bf16x8 qf = __builtin_bit_cast(bf16x8, ((u32x4){lo.x, lo.y, hi.x, hi.y}));
                    oacc[tb] = MFMA16(Sb[m], qf, oacc[tb]); } }
            const int tb = w >> 1;
#pragma unroll
            for (int sbi = 0; sbi < 2; ++sbi) { const int sb = 2 * (w & 1) + sbi; f32x4 a = {0.f, 0.f, 0.f, 0.f};
                if (sb <= tb) {
#pragma unroll
                    for (int m = 0; m < 4; ++m) { const bf16x8 ka = *(const bf16x8*)(lds + L_KH + (16 * sb + fr) * 272 + (32 * m + 8 * q) * 2), qb = *(const bf16x8*)(lds + L_QH + (16 * tb + fr) * 272 + (32 * m + 8 * q) * 2);
                        a = MFMA16(ka, qb, a); }
                    const int tabs = 16 * tb + fr, s0 = 16 * sb + 4 * q;
#pragma unroll
                    for (int j = 0; j < 4; ++j) a[j] = (s0 + j <= tabs) ? a[j] : 0.f;
                }
                u32x2 wv; wv.x = cvt_pk_bf16(a[0], a[1]); wv.y = cvt_pk_bf16(a[2], a[3]);
                *(u32x2*)(lds + L_SC + (16 * tb + fr) * 144 + (16 * sb + 4 * q) * 2) = wv; }
            SCAN_BAR();
        }
        bf16x8 Vf[2];
#pragma unroll
        for (int n = 0; n < 2; ++n) Vf[n] = *(const bf16x8*)(lds + L_VT + (16 * w + fr) * 144 + (32 * n + 8 * q) * 2);
        if (OUT) {
#pragma unroll
            for (int tb = 0; tb < 4; ++tb) {
#pragma unroll
                for (int n = 0; n < 2; ++n) { const bf16x8 sf = *(const bf16x8*)(lds + L_SC + (16 * tb + fr) * 144 + (32 * n + 8 * q) * 2); oacc[tb] = MFMA16(Vf[n], sf, oacc[tb]); }
                const size_t row = (size_t)(r0 + rs * (64 * c + 16 * tb + fr));
                u32x2 wv; wv.x = cvt_pk_bf16(oacc[tb][0], oacc[tb][1]); wv.y = cvt_pk_bf16(oacc[tb][2], oacc[tb][3]);
                *(u32x2*)(Op + row * 1024 + hcol + 16 * w + 4 * q) = wv; }
        }
#pragma unroll
        for (int kt = 0; kt < 8; ++kt) {
#pragma unroll
            for (int n = 0; n < 2; ++n) { const bf16x8 kf = *(const bf16x8*)(lds + L_KHT + (16 * kt + fr) * 144 + (32 * n + 8 * q) * 2); S[kt] = MFMA16(kf, Vf[n], S[kt]); }
            S[kt] *= *(const f32x4*)(EBR + 16 * kt + 4 * q); }
    }
}
template <bool OUT>
__device__ __forceinline__ void scan_run(unsigned char* lds, const unsigned short* Gp, const bf16_t* Vp, const bf16_t* Qp, bf16_t* Op,
                                         int r0, int rs, int chunk0, int nchunks, int gcol, int hcol, f32x4 (&S)[8], f32x2& dtot) {
    const int lane = threadIdx.x & 63, w = __builtin_amdgcn_readfirstlane(threadIdx.x >> 6);
    constexpr int GR = OUT ? 2 : 4;
    unsigned gk[GR][8], vv[GR][8], qq[GR][8];
    const int end = chunk0 + nchunks;
#pragma unroll
    for (int g = 0; g < GR; ++g) SCAN_LOADB(gk[g], vv[g], qq[g], chunk0 + g);
    for (int c = chunk0; c < end; c += GR) {
#pragma unroll
        for (int g = 0; g < GR; ++g) scan_chunk<OUT>(lds, Gp, Vp, Qp, Op, r0, rs, c + g, (c + g + GR < end) ? c + g + GR : -1, gcol, hcol, S, dtot, gk[g], vv[g], qq[g]);
    }
    __syncthreads();
}
#undef SCAN_LOADB
#undef SCAN_BAR

__device__ __forceinline__ void phase_scan1(const Params& p, unsigned char* lds) {
    const int tid = threadIdx.x, lane = tid & 63, w = tid >> 6;
    const unsigned short* Gp = (const unsigned short*)(p.ws + WS_G); const bf16_t* Vp = (const bf16_t*)(p.ws + WS_V);
    for (int item = blockIdx.x; item < 256; item += gridDim.x) {
        const int seq = item >> 3, seg = item & 7, dir = seq >> 4, b = (seq >> 3) & 1, h = seq & 7;
        f32x4 S[8];
#pragma unroll
        for (int kt = 0; kt < 8; ++kt) S[kt] = (f32x4){0.f, 0.f, 0.f, 0.f};
        f32x2 dtot = {0.f, 0.f};
        if (seg < 7) scan_run<false>(lds, Gp, Vp, nullptr, nullptr, dir ? b * SEQ + SEQ - 1 : b * SEQ, dir ? -1 : 1, seg * 32, 32, dir * 1024 + h * 128, h * 128, S, dtot);
        else scan_run<false>(lds, Gp, Vp, nullptr, nullptr, dir ? T + b * CTXL + CTXL - 1 : T + b * CTXL, dir ? -1 : 1, 0, 4, dir * 1024 + h * 128, h * 128, S, dtot);
        float* dst = (float*)(p.ws + WS_SEG) + ((size_t)(seq * 8 + seg) * 8 + w) * 2048;
#pragma unroll
        for (int kt = 0; kt < 8; ++kt)
#pragma unroll
            for (int j = 0; j < 4; ++j) dst[(kt * 4 + j) * 64 + lane] = S[kt][j];
        if (w == 0) *(f32x2*)((float*)(p.ws + WS_SEGDEC) + (seq * 8 + seg) * 128 + 2 * lane) = dtot;
    }
}
__device__ __forceinline__ void phase_scan2(const Params& p, unsigned char* lds) {
    const int tid = threadIdx.x, lane = tid & 63, w = tid >> 6, q = lane >> 4;
    const unsigned short* Gp = (const unsigned short*)(p.ws + WS_G); const bf16_t* Vp = (const bf16_t*)(p.ws + WS_V); const bf16_t* Qp = (const bf16_t*)(p.ws + WS_Q);
    for (int item = blockIdx.x; item < 256; item += gridDim.x) {
        const int seq = item >> 3, seg = item & 7, dir = seq >> 4, b = (seq >> 3) & 1, h = seq & 7;
        f32x4 S[8];
        const float* segb = (const float*)(p.ws + WS_SEG) + ((size_t)(seq * 8) * 8 + w) * 2048; const float* decb = (const float*)(p.ws + WS_SEGDEC) + (seq * 8) * 128;
#pragma unroll
        for (int kt = 0; kt < 8; ++kt)
#pragma unroll
            for (int j = 0; j < 4; ++j) S[kt][j] = segb[(size_t)7 * 8 * 2048 + (kt * 4 + j) * 64 + lane];
        int s = 0;
        for (; s + 1 < seg; s += 2) {
            f32x4 La[8], Lb[8], Da[8], Db[8];
#pragma unroll
            for (int kt = 0; kt < 8; ++kt) { Da[kt] = *(const f32x4*)(decb + s * 128 + 16 * kt + 4 * q); Db[kt] = *(const f32x4*)(decb + (s + 1) * 128 + 16 * kt + 4 * q);
#pragma unroll
                for (int j = 0; j < 4; ++j) { La[kt][j] = segb[(size_t)s * 8 * 2048 + (kt * 4 + j) * 64 + lane]; Lb[kt][j] = segb[(size_t)(s + 1) * 8 * 2048 + (kt * 4 + j) * 64 + lane]; } }
#pragma unroll
            for (int kt = 0; kt < 8; ++kt)
#pragma unroll
                for (int j = 0; j < 4; ++j) S[kt][j] = __expf(Db[kt][j]) * (__expf(Da[kt][j]) * S[kt][j] + La[kt][j]) + Lb[kt][j];
        }
        if (s < seg) {
#pragma unroll
            for (int kt = 0; kt < 8; ++kt)
#pragma unroll
                for (int j = 0; j < 4; ++j) S[kt][j] = __expf(decb[s * 128 + 16 * kt + 4 * q + j]) * S[kt][j] + segb[(size_t)s * 8 * 2048 + (kt * 4 + j) * 64 + lane];
        }
        f32x2 dtot = {0.f, 0.f};
        bf16_t* Op = (bf16_t*)(p.ws + WS_O) + (size_t)dir * T * HW;
        scan_run<true>(lds, Gp, Vp, Qp, Op, dir ? b * SEQ + SEQ - 1 : b * SEQ, dir ? -1 : 1, seg * 32, 32, dir * 1024 + h * 128, h * 128, S, dtot);
    }
}

__device__ __forceinline__ void phase_combine(const Params& p) {
    const int lane = threadIdx.x & 63, gw = blockIdx.x * 8 + (threadIdx.x >> 6), NGW = gridDim.x * 8;
    const bf16_t* Of = (const bf16_t*)(p.ws + WS_O); const bf16_t* Ob = Of + (size_t)T * HW; const bf16_t* GT = (const bf16_t*)(p.ws + WS_GATE);
    const bf16_t* BG = (const bf16_t*)(p.ws + WS_BG); const bf16_t* P = (const bf16_t*)(p.ws + WS_P); bf16_t* Y = (bf16_t*)(p.ws + WS_Y);
    const int c0 = 16 * lane;
    {
        float gw_[16];
#pragma unroll
        for (int j = 0; j < 16; ++j) gw_[j] = p.g_norm_w[(c0 + j) & 127];
        u32x4 a[2][2], b[2][2], g[2][2], na[2][2], nb[2][2], ng[2][2];
#define HG_LOAD(A_, B_, G_, tk0) do { _Pragma("unroll") for (int u = 0; u < 2; ++u) { const int tk_ = ((tk0) + u * NGW < T) ? (tk0) + u * NGW : gw; \
            _Pragma("unroll") for (int i = 0; i < 2; ++i) { const size_t off = (size_t)tk_ * 1024 + c0 + 8 * i; A_[u][i] = *(const u32x4*)(Of + off); B_[u][i] = *(const u32x4*)(Ob + off); G_[u][i] = *(const u32x4*)(GT + off); } } } while (0)
        HG_LOAD(a, b, g, gw);
#pragma unroll
        for (int u = 0; u < 2; ++u)
#pragma unroll
            for (int i = 0; i < 2; ++i) { na[u][i] = a[u][i]; nb[u][i] = b[u][i]; ng[u][i] = g[u][i]; }
        for (int tok0 = gw; tok0 < T; tok0 += 2 * NGW) {
            if (tok0 + 2 * NGW < T) HG_LOAD(na, nb, ng, tok0 + 2 * NGW);
#pragma unroll
            for (int u = 0; u < 2; ++u) {
                const int tok = tok0 + u * NGW; if (tok >= T) break;
                float o[16], gt[16]; float ss = 0.f;
#pragma unroll
                for (int i = 0; i < 2; ++i)
#pragma unroll
                    for (int j = 0; j < 4; ++j) { const unsigned ua = a[u][i][j], ub = b[u][i][j], ug = g[u][i][j];
                        const float lo = __uint_as_float(ua << 16) + __uint_as_float(ub << 16), hi = __uint_as_float(ua & 0xffff0000u) + __uint_as_float(ub & 0xffff0000u);
                        o[8 * i + 2 * j] = lo; o[8 * i + 2 * j + 1] = hi; ss += lo * lo + hi * hi; gt[8 * i + 2 * j] = silu_f(__uint_as_float(ug << 16)); gt[8 * i + 2 * j + 1] = silu_f(__uint_as_float(ug & 0xffff0000u)); }
                ss += __shfl_xor(ss, 1); ss += __shfl_xor(ss, 2); ss += __shfl_xor(ss, 4);
                const float rstd = 1.f / sqrtf(ss * (1.f / 128.f) + RMS_EPS);
                u32x4 w[2];
#pragma unroll
                for (int i = 0; i < 2; ++i)
#pragma unroll
                    for (int j = 0; j < 4; ++j) w[i][j] = cvt_pk_bf16(o[8 * i + 2 * j] * rstd * gw_[8 * i + 2 * j] * gt[8 * i + 2 * j], o[8 * i + 2 * j + 1] * rstd * gw_[8 * i + 2 * j + 1] * gt[8 * i + 2 * j + 1]);
                bf16_t* yr = Y + (size_t)tok * D + c0;
                *(u32x4*)yr = w[0]; *(u32x4*)(yr + 8) = w[1];
            }
#pragma unroll
            for (int u = 0; u < 2; ++u)
#pragma unroll
                for (int i = 0; i < 2; ++i) { a[u][i] = na[u][i]; b[u][i] = nb[u][i]; g[u][i] = ng[u][i]; }
        }
#undef HG_LOAD
    }
    {
        float cw0[16], cw1[16], cw2[16];
#pragma unroll
        for (int j = 0; j < 16; ++j) { cw0[j] = p.conv_w[c0 + j]; cw1[j] = p.conv_w[1024 + c0 + j]; cw2[j] = p.conv_w[2048 + c0 + j]; }
        u32x4 pc[2][2], pp[2][2], pn[2][2], bg[2][2], npc[2][2], npp[2][2], npn[2][2], nbg[2][2];
#define CONV_LOAD(tk0, PC, PP, PN, BGv) do { _Pragma("unroll") for (int u = 0; u < 2; ++u) { const int tk_ = ((tk0) + u * NGW < T) ? (tk0) + u * NGW : gw; \
            const int tt_ = tk_ & 63; const bool hp_ = tt_ != 0, hn_ = tt_ != 63; _Pragma("unroll") for (int i = 0; i < 2; ++i) { const size_t off = (size_t)tk_ * 1024 + c0 + 8 * i; \
            PC[u][i] = *(const u32x4*)(P + off); BGv[u][i] = *(const u32x4*)(BG + off); PP[u][i] = hp_ ? *(const u32x4*)(P + off - 1024) : (u32x4){0, 0, 0, 0}; PN[u][i] = hn_ ? *(const u32x4*)(P + off + 1024) : (u32x4){0, 0, 0, 0}; } } } while (0)
        CONV_LOAD(gw, pc, pp, pn, bg);
#pragma unroll
        for (int u = 0; u < 2; ++u)
#pragma unroll
            for (int i = 0; i < 2; ++i) { npc[u][i] = pc[u][i]; npp[u][i] = pp[u][i]; npn[u][i] = pn[u][i]; nbg[u][i] = bg[u][i]; }
        for (int tok0 = gw; tok0 < T; tok0 += 2 * NGW) {
            if (tok0 + 2 * NGW < T) CONV_LOAD(tok0 + 2 * NGW, npc, npp, npn, nbg);
#pragma unroll
            for (int u = 0; u < 2; ++u) {
                const int tok = tok0 + u * NGW; if (tok >= T) break;
                u32x4 w[2];
#pragma unroll
                for (int i = 0; i < 2; ++i)
#pragma unroll
                    for (int j = 0; j < 4; ++j) { const int e = 8 * i + 2 * j;
                        const float lo = __uint_as_float(bg[u][i][j] << 16) * (cw0[e] * __uint_as_float(pp[u][i][j] << 16) + cw1[e] * __uint_as_float(pc[u][i][j] << 16) + cw2[e] * __uint_as_float(pn[u][i][j] << 16));
                        const float hi = __uint_as_float(bg[u][i][j] & 0xffff0000u) * (cw0[e + 1] * __uint_as_float(pp[u][i][j] & 0xffff0000u) + cw1[e + 1] * __uint_as_float(pc[u][i][j] & 0xffff0000u) + cw2[e + 1] * __uint_as_float(pn[u][i][j] & 0xffff0000u));
                        w[i][j] = cvt_pk_bf16(lo, hi); }
                bf16_t* yr = Y + (size_t)tok * D + 1024 + c0;
                *(u32x4*)yr = w[0]; *(u32x4*)(yr + 8) = w[1];
            }
#pragma unroll
            for (int u = 0; u < 2; ++u)
#pragma unroll
                for (int i = 0; i < 2; ++i) { pc[u][i] = npc[u][i]; pp[u][i] = npp[u][i]; pn[u][i] = npn[u][i]; bg[u][i] = nbg[u][i]; }
        }
#undef CONV_LOAD
    }
}

#define LNH_STATS(v, mean, rstd) do { float s_ = 0.f; \
        _Pragma("unroll") for (int j = 0; j < 4; ++j) _Pragma("unroll") for (int e = 0; e < 8; e += 2) s_ += v[j][e] + v[j][e + 1]; \
        mean = wave_sum(s_) * (1.f / D); float s2_ = 0.f; \
        _Pragma("unroll") for (int j = 0; j < 4; ++j) _Pragma("unroll") for (int e = 0; e < 8; ++e) { v[j][e] -= mean; s2_ += v[j][e] * v[j][e]; } \
        rstd = 1.f / sqrtf(wave_sum(s2_) * (1.f / D) + LN_EPS); } while (0)
__device__ __forceinline__ void phase_ln_mid(const Params& p) {
    const int lane = threadIdx.x & 63, gw = blockIdx.x * 8 + (threadIdx.x >> 6), NGW = gridDim.x * 8;
    const float* modv = (const float*)(p.ws + WS_MOD); bf16_t* H = (bf16_t*)(p.ws + WS_H); const unsigned short* U1 = (const unsigned short*)(p.ws + WS_U1); float* stats = (float*)(p.ws + WS_STATS);
    f32x4 G1[4][2], B1[4][2];
#pragma unroll
    for (int j = 0; j < 4; ++j)
#pragma unroll
        for (int h = 0; h < 2; ++h) { const int c = 8 * (lane + 64 * j) + 4 * h; G1[j][h] = *(const f32x4*)(p.ln1_g + c); B1[j][h] = *(const f32x4*)(p.ln1_b + c); }
    for (int row0 = gw; row0 < T; row0 += 2 * NGW) {
        const int row1 = (row0 + NGW < T) ? row0 + NGW : row0;
        u32x4 ra[4], rb[4];
#pragma unroll
        for (int j = 0; j < 4; ++j) { ra[j] = ((const u32x4*)(U1 + (size_t)row0 * D) + lane)[64 * j]; rb[j] = ((const u32x4*)(U1 + (size_t)row1 * D) + lane)[64 * j]; }
#pragma unroll
        for (int r = 0; r < 2; ++r) {
            if (r == 1 && row1 == row0) break;
            const int row = r == 0 ? row0 : row1;
            const float* mv = modv + (row < SEQ ? 0 : 12288);
            float v[4][8];
#pragma unroll
            for (int j = 0; j < 4; ++j) unpack_h8(r == 0 ? ra[j] : rb[j], v[j]);
            float mean, rstd; LNH_STATS(v, mean, rstd);
            if (lane == 0) *(f32x2*)(stats + 2 * row) = (f32x2){mean, rstd};
#pragma unroll
            for (int j = 0; j < 4; ++j) { const int c = 8 * (lane + 64 * j);
#pragma unroll
                for (int h = 0; h < 2; ++h) { const f32x4 g = G1[j][h], bb = B1[j][h];
#pragma unroll
                    for (int e = 0; e < 4; ++e) v[j][4 * h + e] = (v[j][4 * h + e] * rstd) * g[e] + bb[e]; } }
            float mean2, rstd2; LNH_STATS(v, mean2, rstd2);
            u32x4* o16 = (u32x4*)(H + (size_t)row * D) + lane;
#pragma unroll
            for (int j = 0; j < 4; ++j) { const int c = 8 * (lane + 64 * j); float hh[8];
#pragma unroll
                for (int h = 0; h < 2; ++h) { const f32x4 sh = *(const f32x4*)(mv + 3 * 2048 + c + 4 * h), sc = *(const f32x4*)(mv + 4 * 2048 + c + 4 * h);
#pragma unroll
                    for (int e = 0; e < 4; ++e) hh[4 * h + e] = (v[j][4 * h + e] * rstd2) * (1.f + sc[e]) + sh[e]; }
                u32x4 w; w.x = cvt_pk_bf16(hh[0], hh[1]); w.y = cvt_pk_bf16(hh[2], hh[3]); w.z = cvt_pk_bf16(hh[4], hh[5]); w.w = cvt_pk_bf16(hh[6], hh[7]); o16[64 * j] = w; }
        }
    }
}
__device__ __forceinline__ void phase_ln_out(const Params& p) {
    const int lane = threadIdx.x & 63, gw = blockIdx.x * 8 + (threadIdx.x >> 6), NGW = gridDim.x * 8;
    const unsigned short* U2 = (const unsigned short*)(p.ws + WS_H);
    f32x4 G2[4][2], B2[4][2];
#pragma unroll
    for (int j = 0; j < 4; ++j)
#pragma unroll
        for (int h = 0; h < 2; ++h) { const int c = 8 * (lane + 64 * j) + 4 * h; G2[j][h] = *(const f32x4*)(p.ln2_g + c); B2[j][h] = *(const f32x4*)(p.ln2_b + c); }
    for (int row0 = gw; row0 < T; row0 += 2 * NGW) {
        const int row1 = (row0 + NGW < T) ? row0 + NGW : row0;
        u32x4 ra[4], rb[4];
#pragma unroll
        for (int j = 0; j < 4; ++j) { ra[j] = ((const u32x4*)(U2 + (size_t)row0 * D) + lane)[64 * j]; rb[j] = ((const u32x4*)(U2 + (size_t)row1 * D) + lane)[64 * j]; }
#pragma unroll
        for (int r = 0; r < 2; ++r) {
            if (r == 1 && row1 == row0) break;
            float v[4][8];
#pragma unroll
            for (int j = 0; j < 4; ++j) unpack_h8(r == 0 ? ra[j] : rb[j], v[j]);
            float mean, rstd; LNH_STATS(v, mean, rstd);
            float* orow = p.out + (size_t)(r == 0 ? row0 : row1) * D;
#pragma unroll
            for (int j = 0; j < 4; ++j) { const int c = 8 * (lane + 64 * j);
#pragma unroll
                for (int h = 0; h < 2; ++h) { const f32x4 g = G2[j][h], bb = B2[j][h]; f32x4 o;
#pragma unroll
                    for (int e = 0; e < 4; ++e) o[e] = (v[j][4 * h + e] * rstd) * g[e] + bb[e];
                    *(f32x4*)(orow + c + 4 * h) = o; } }
        }
    }
}

__global__ void __launch_bounds__(512, 2) hymba_fwd(Params p) {
    extern __shared__ __attribute__((aligned(16))) unsigned char shm[];
    cg::grid_group grid = cg::this_grid();
    PG8_LAS unsigned char* lds3 = (PG8_LAS unsigned char*)shm;
    const int lo = p.lo, hi = p.hi;
#define IN(k) (lo <= (k) && (k) < hi)
    if (threadIdx.x == 0) { *(volatile PG8_LAS unsigned*)(lds3 + pg8::STAGE_BYTES) = 0u; *(volatile PG8_LAS unsigned*)(lds3 + pg8::STAGE_BYTES + 4) = 0u; }
    __syncthreads();
    XcdBarrier xbar = xcd_barrier_post((unsigned*)(p.ws + WS_BAR), (volatile PG8_LAS unsigned*)(lds3 + pg8::STAGE_BYTES));
    if (lo < 0) grid.sync();
#define SEAM(k) do { if ((k) + 1 < hi) xcd_barrier(xbar); } while (0)
    if (IN(0)) { phase_prep(p, shm); SEAM(0); }
    if (IN(1)) {
        const int NCW = (gridDim.x >= 64) ? 24 : 0;
        if ((int)blockIdx.x < NCW) {
            const int cb = (int)blockIdx.x / 12, cpn = (int)blockIdx.x % 12;
            ln_ctx_rows(p, T + cb * CTXL, CTXL);
            asm volatile("s_waitcnt vmcnt(0)" ::: "memory"); __syncthreads();
            pg8::Gemm g{(const bf16_t*)(p.ws + WS_H), (const bf16_t*)(p.ws + WS_WIN), TALL, NIN, D}; OneUnit S1{T / 256 + cb, cpn};
            EpiIn E{(unsigned short*)(p.ws + WS_G), (bf16_t*)(p.ws + WS_V), (bf16_t*)(p.ws + WS_Q), (bf16_t*)(p.ws + WS_GATE), (bf16_t*)(p.ws + WS_BG), (bf16_t*)(p.ws + WS_P), (const float*)(p.ws + WS_LB)};
            pg8::gemm_phase<EpiIn, OneUnit>(lds3, g, S1, E);
        } else {
            if (NCW == 0) phase_ln_in(p, T, TALL, (int)(blockIdx.x * 8 + (threadIdx.x >> 6)), (int)gridDim.x * 8);
            phase_ln_in(p, 0, T, (int)((blockIdx.x - NCW) * 8 + (threadIdx.x >> 6)), (int)(gridDim.x - NCW) * 8);
        }
        SEAM(1);
    }
    if (IN(2)) {
        const int Min = (gridDim.x >= 64) ? T : TALL;
        pg8::Gemm g{(const bf16_t*)(p.ws + WS_H), (const bf16_t*)(p.ws + WS_WIN), Min, NIN, D}; pg8::StaticOrder S; S.init(Min, NIN, (int)gridDim.x, (int)blockIdx.x);
        EpiIn E{(unsigned short*)(p.ws + WS_G), (bf16_t*)(p.ws + WS_V), (bf16_t*)(p.ws + WS_Q), (bf16_t*)(p.ws + WS_GATE), (bf16_t*)(p.ws + WS_BG), (bf16_t*)(p.ws + WS_P), (const float*)(p.ws + WS_LB)};
        pg8::gemm_phase<EpiIn, pg8::StaticOrder>(lds3, g, S, E); SEAM(2);
    }
    if (IN(3)) { phase_scan1(p, shm); SEAM(3); }
    if (IN(4)) { phase_scan2(p, shm); SEAM(4); }
    if (IN(5)) { phase_combine(p); SEAM(5); }
    if (IN(6)) {
        pg8::Gemm g{(const bf16_t*)(p.ws + WS_Y), (const bf16_t*)(p.ws + WS_WOUT), T, D, D}; pg8::StaticOrder S; S.init(T, D, (int)gridDim.x, (int)blockIdx.x);
        EpiOut E{p.x, (const float*)(p.ws + WS_MOD), (unsigned short*)(p.ws + WS_U1)};
        pg8::gemm_phase<EpiOut, pg8::StaticOrder>(lds3, g, S, E); SEAM(6);
    }
    if (IN(7)) { phase_ln_mid(p); SEAM(7); }
    if (IN(8)) {
        pg8::Gemm g{(const bf16_t*)(p.ws + WS_H), (const bf16_t*)(p.ws + WS_WGU), T, NGU, D}; pg8::StaticOrder S; S.init(T, NGU, (int)gridDim.x, (int)blockIdx.x);
        EpiGU E{(bf16_t*)(p.ws + WS_HID)};
        pg8::gemm_phase<EpiGU, pg8::StaticOrder>(lds3, g, S, E); SEAM(8);
    }
    if (IN(9)) {
        pg8::Gemm g{(const bf16_t*)(p.ws + WS_HID), (const bf16_t*)(p.ws + WS_WDN), T, D, DFF}; pg8::StaticOrder S; S.init(T, D, (int)gridDim.x, (int)blockIdx.x);
        EpiDown E{(const unsigned short*)(p.ws + WS_U1), (const float*)(p.ws + WS_STATS), (const float*)(p.ws + WS_MOD), p.ln1_g, p.ln1_b, (unsigned short*)(p.ws + WS_H)};
        pg8::gemm_phase<EpiDown, pg8::StaticOrder>(lds3, g, S, E); SEAM(9);
    }
    if (IN(10)) { phase_ln_out(p); }
#undef IN
#undef SEAM
}

extern "C" void kernel_launch(void* const* d_in, const int* in_sizes, int n_in, void* d_out, int out_size, void* d_ws, size_t ws_size, hipStream_t stream) {
    constexpr int LDS_BYTES = pg8::STAGE_BYTES + 16;
    static int grid = 0;
    if (grid == 0) {
        if (n_in != 18 || ws_size < WS_END) { fprintf(stderr, "kernel_launch: unexpected inputs (n_in %d, ws %zu < %zu)\n", n_in, ws_size, (size_t)WS_END); grid = -1; return; }
        int dev = 0, cus = 0, per_cu = 0;
        (void)hipGetDevice(&dev); (void)hipDeviceGetAttribute(&cus, hipDeviceAttributeMultiprocessorCount, dev);
        if (hipFuncSetAttribute((const void*)hymba_fwd, hipFuncAttributeMaxDynamicSharedMemorySize, LDS_BYTES) != hipSuccess) { fprintf(stderr, "kernel_launch: hipFuncSetAttribute failed\n"); grid = -1; return; }
        if (hipOccupancyMaxActiveBlocksPerMultiprocessor(&per_cu, (const void*)hymba_fwd, 512, LDS_BYTES) != hipSuccess || per_cu < 1) { fprintf(stderr, "kernel_launch: occupancy query says %d\n", per_cu); per_cu = 1; }
        (void)hipGetLastError();
        grid = cus * 1;
    }
    if (grid < 0) return;
    if (hipMemsetAsync((char*)d_ws + WS_BAR, 0, 16384, stream) != hipSuccess) { fprintf(stderr, "kernel_launch: memset of the barrier words failed\n"); return; }
    Params p{};
    const float** pp = (const float**)&p;
    for (int i = 0; i < 18; ++i) pp[i] = (const float*)d_in[i];
    p.out = (float*)d_out; p.ws = (unsigned char*)d_ws;
#if ONE_LAUNCH
    p.lo = 0; p.hi = 11;
    void* args[] = {&p};
    hipError_t e = hipLaunchCooperativeKernel((const void*)hymba_fwd, dim3(grid), dim3(512), args, LDS_BYTES, stream);
    if (e != hipSuccess) fprintf(stderr, "cooperative launch failed: %s (grid %d)\n", hipGetErrorString(e), grid);
#else
    for (int k = 0; k < 11; ++k) { p.lo = k; p.hi = k + 1; hipLaunchKernelGGL(hymba_fwd, dim3(grid), dim3(512), LDS_BYTES, stream, p); }
#endif
}
```

```cpp
#include <hip/hip_runtime.h>
#include <hip/hip_cooperative_groups.h>
#include <cstdio>
namespace cg = cooperative_groups;

#ifndef ONE_LAUNCH
#define ONE_LAUNCH 1
#endif

#define PG8_LAS __attribute__((address_space(3)))
typedef unsigned short bf16_t;
typedef short bf16x8 __attribute__((ext_vector_type(8)));
typedef float f32x4 __attribute__((ext_vector_type(4)));
typedef float f32x2 __attribute__((ext_vector_type(2)));
typedef unsigned u32x4 __attribute__((ext_vector_type(4)));
typedef unsigned u32x2 __attribute__((ext_vector_type(2)));
typedef _Float16 h16x2 __attribute__((ext_vector_type(2)));

constexpr int D = 2048, T = 32768, TALL = 33280, SEQ = 16384, CTXL = 256, HW = 1024, NIN = 8192, DFF = 5632, NGU = 11264;
constexpr float ALPHA = 1.189207115002721f, LN_EPS = 1e-6f, RMS_EPS = 1e-6f;

constexpr size_t WS_WIN = 0;
constexpr size_t WS_WOUT = WS_WIN + (size_t)NIN * D * 2;
constexpr size_t WS_WGU = WS_WOUT + (size_t)D * D * 2;
constexpr size_t WS_WDN = WS_WGU + (size_t)NGU * D * 2;
constexpr size_t WS_MOD = WS_WDN + (size_t)D * DFF * 2;
constexpr size_t WS_LB = WS_MOD + 3 * 12288 * 4;
constexpr size_t WS_STATS = WS_LB + 2048 * 4;
constexpr size_t WS_SEG = WS_STATS + (size_t)T * 8;
constexpr size_t WS_SEGDEC = WS_SEG + (size_t)32 * 8 * 65536;
constexpr size_t WS_H = WS_SEGDEC + 32 * 8 * 128 * 4;
constexpr size_t WS_V = WS_H + (size_t)TALL * D * 2;
constexpr size_t WS_Q = WS_V + (size_t)TALL * HW * 2;
constexpr size_t WS_GATE = WS_Q + (size_t)T * HW * 2;
constexpr size_t WS_BG = WS_GATE + (size_t)T * HW * 2;
constexpr size_t WS_U1 = WS_V;
constexpr size_t WS_P = WS_BG + (size_t)T * HW * 2;
constexpr size_t WS_G = WS_P + (size_t)T * HW * 2;
constexpr size_t WS_Y = WS_G;
constexpr size_t WS_O = WS_G + (size_t)TALL * D * 2;
constexpr size_t WS_HID = WS_P;
constexpr size_t WS_BAR = WS_HID + (size_t)T * DFF * 2;
constexpr size_t WS_END = WS_BAR + 16384;
static_assert(WS_O + (size_t)2 * T * HW * 2 <= WS_END, "ws map");
static_assert(WS_U1 + (size_t)T * D * 4 <= WS_P, "ws map u1");

typedef __bf16 bf16v2_t __attribute__((ext_vector_type(2)));
__device__ __forceinline__ unsigned cvt_pk_bf16(float lo, float hi) { const bf16v2_t v = __builtin_convertvector((f32x2){lo, hi}, bf16v2_t); return __builtin_bit_cast(unsigned, v); }
__device__ __forceinline__ float bf2f(unsigned short b) { return __uint_as_float(((unsigned)b) << 16); }
__device__ __forceinline__ float h2f(unsigned short b) { return (float)__builtin_bit_cast(_Float16, b); }
__device__ __forceinline__ unsigned pk_h2(float a, float b) { h16x2 v; v.x = (_Float16)a; v.y = (_Float16)b; return __builtin_bit_cast(unsigned, v); }
__device__ __forceinline__ void unpack_h8(const u32x4 w, float (&f)[8]) {
#pragma unroll
    for (int i = 0; i < 4; ++i) { const h16x2 h = __builtin_bit_cast(h16x2, (unsigned)w[i]); f[2 * i] = (float)h.x; f[2 * i + 1] = (float)h.y; }
}
__device__ __forceinline__ float silu_f(float v) { return v * __builtin_amdgcn_rcpf(1.0f + __expf(-v)); }
__device__ __forceinline__ float wave_sum(float v) {
#pragma unroll
    for (int o = 1; o < 64; o <<= 1) v += __shfl_xor(v, o);
    return v;
}

namespace pg8 {
constexpr int BM = 256, BK = 64, HALF = 128, HTB = HALF * BK * 2, STAGE_BYTES = 8 * HTB, NXCD = 8, WGM = 8;
__host__ __device__ __forceinline__ int lds_byte(int r, int c) { const int st = (r >> 4) * 2 + (c >> 5), rr = r & 15, cc = c & 31, ob = rr * 64 + cc * 2; return st * 1024 + (ob ^ (((ob >> 9) & 1) << 5)); }
__host__ __device__ __forceinline__ void stage_rc(int b, int& R, int& C) { const int st = b / 1024, sb = b % 1024, swz = sb ^ (((sb >> 9) & 1) << 5); R = (st >> 1) * 16 + swz / 64; C = (st & 1) * 32 + (swz % 64) / 2; }
__host__ __device__ __forceinline__ int perm32(int rho) { const int n = rho >> 4, i = rho & 15; return 8 * (i >> 2) + 4 * n + (i & 3); }
struct Unit { int pm, pn; };
struct Gemm { const bf16_t* A; const bf16_t* Bt; int M, N, K; };
struct StaticOrder {
    int nM, nN, nwg, G, c;
    __host__ __device__ void init(int M, int N, int G_, int c_) { nM = M / BM; nN = N / BM; nwg = nM * nN; G = G_; c = c_; }
    __host__ __device__ bool next(int i, Unit& u) const {
        const long L = (long)i * G + c; if (L >= nwg) return false;
        int wgid = (int)L; { const int q = nwg / NXCD, r = nwg % NXCD, xcd = wgid % NXCD, off = wgid / NXCD; wgid = (xcd < r ? xcd * (q + 1) : r * (q + 1) + (xcd - r) * q) + off; }
        const int nig = WGM * nN, gid = wgid / nig, fm = gid * WGM, gsz = (nM - fm) < WGM ? (nM - fm) : WGM;
        u.pm = fm + ((wgid % nig) % gsz); u.pn = (wgid % nig) / gsz; return true;
    }
    __device__ __forceinline__ void a_ready(const Unit&) const {}
    __device__ __forceinline__ void done(const Unit&) const {}
};

template <class Epi, class Sched>
__device__ __forceinline__ void gemm_phase(PG8_LAS unsigned char* lds, const Gemm g, const Sched& S, const Epi& E) {
    const int tid = threadIdx.x, wid = __builtin_amdgcn_readfirstlane(tid >> 6), lane = tid & 63, wr = wid >> 2, wc = wid & 3, fr = lane & 15, fq = lane >> 4;
    const int K = g.K, nt = K / BK;
    unsigned voffA[2], voffB[2];
#pragma unroll
    for (int i = 0; i < 2; ++i) { int R, C; stage_rc(tid * 16 + i * 8192, R, C); const int Rb = Epi::PERM ? ((R & ~31) + perm32(R & 31)) : R;
        voffA[i] = (unsigned)(R * K + C) * 2u; voffB[i] = (unsigned)(Rb * K + C) * 2u; }
    const size_t kstep = (size_t)(BK * 2);
    const size_t hstep = (size_t)HALF * K * 2;
    const size_t tstep = 2 * hstep;
    const unsigned ldsw = (unsigned)wid * 1024u;
    const int aoff = lds_byte(wr * 64 + fr, fq * 8), boff = lds_byte(wc * 32 + fr, fq * 8);
#define PG8_SA(b, h) (((b) * 2 + (h)) * HTB)
#define PG8_SB(b, h) ((4 + (b) * 2 + (h)) * HTB)
#define PG8_STAGE(bufoff, gbase, voff) do { _Pragma("unroll") for (int _i = 0; _i < 2; ++_i) \
        __builtin_amdgcn_global_load_lds((const unsigned*)((const char*)(gbase) + (voff)[_i]), (PG8_LAS unsigned*)(lds + (bufoff) + ldsw + _i * 8192), 16, 0, 0); } while (0)
#define PG8_LDA(dst, b, h) do { _Pragma("unroll") for (int m = 0; m < 4; ++m) _Pragma("unroll") for (int k = 0; k < 2; ++k) dst[m][k] = *(const PG8_LAS bf16x8*)(lds + PG8_SA(b, h) + aoff + m * 2048 + k * 1024); } while (0)
#define PG8_LDB(dst, b, h) do { _Pragma("unroll") for (int n = 0; n < 2; ++n) _Pragma("unroll") for (int k = 0; k < 2; ++k) dst[n][k] = *(const PG8_LAS bf16x8*)(lds + PG8_SB(b, h) + boff + n * 2048 + k * 1024); } while (0)
#define PG8_MMA(ai, bj, At, Bt) do { __builtin_amdgcn_s_setprio(1); _Pragma("unroll") for (int m = 0; m < 4; ++m) _Pragma("unroll") for (int n = 0; n < 2; ++n) _Pragma("unroll") for (int k = 0; k < 2; ++k) \
        acc[ai][bj][m][n] = __builtin_amdgcn_mfma_f32_16x16x32_bf16(Bt[n][k], At[m][k], acc[ai][bj][m][n], 0, 0, 0); __builtin_amdgcn_s_setprio(0); } while (0)
#define PG8_WAIT_V(n) asm volatile("s_waitcnt vmcnt(" #n ")" ::: "memory")
#define PG8_WAIT_L(n) asm volatile("s_waitcnt lgkmcnt(" #n ")" ::: "memory")
#define PG8_BAR __builtin_amdgcn_s_barrier()
#define PG8_SCHED __builtin_amdgcn_sched_barrier(0)
    Unit cur, nxt; int ui = 0;
    if (!S.next(0, cur)) return;
    f32x4 acc[2][2][4][2];
#pragma unroll
    for (int a = 0; a < 2; ++a)
#pragma unroll
        for (int b = 0; b < 2; ++b)
#pragma unroll
            for (int m = 0; m < 4; ++m)
#pragma unroll
                for (int n = 0; n < 2; ++n) acc[a][b][m][n] = (f32x4){0.f, 0.f, 0.f, 0.f};
    bf16x8 At[4][2], B0[2][2], B1[2][2];
    const char* cA = (const char*)g.A + (size_t)cur.pm * tstep; const char* cB = (const char*)g.Bt + (size_t)cur.pn * tstep;
    S.a_ready(cur);
    PG8_STAGE(PG8_SB(0, 0), cB, voffB); PG8_STAGE(PG8_SA(0, 0), cA, voffA); PG8_STAGE(PG8_SB(0, 1), cB + hstep, voffB); PG8_STAGE(PG8_SA(0, 1), cA + hstep, voffA);
    if (wr == 1) PG8_BAR;
    PG8_WAIT_V(4); PG8_BAR;
    PG8_STAGE(PG8_SB(1, 0), cB + kstep, voffB); PG8_STAGE(PG8_SA(1, 0), cA + kstep, voffA); PG8_STAGE(PG8_SB(1, 1), cB + hstep + kstep, voffB);
    PG8_WAIT_V(6); PG8_BAR;
    for (;;) {
        const bool has_next = S.next(ui + 1, nxt);
        const char* nA = has_next ? (const char*)g.A + (size_t)nxt.pm * tstep : cA; const char* nB = has_next ? (const char*)g.Bt + (size_t)nxt.pn * tstep : cB;
        for (int t = 0; t < nt; t += 2) {
            const bool last = (t == nt - 2);
            const char* a1 = cA + (size_t)(t + 1) * kstep;
            const char* a2 = last ? nA : cA + (size_t)(t + 2) * kstep; const char* b2 = last ? nB : cB + (size_t)(t + 2) * kstep;
            const char* a3 = a2 + kstep; const char* b3 = b2 + kstep;
            if (last && has_next) S.a_ready(nxt);
            PG8_LDB(B0, 0, 0); PG8_SCHED; PG8_LDA(At, 0, 0); PG8_STAGE(PG8_SA(1, 1), a1 + hstep, voffA);
            PG8_WAIT_L(8); PG8_BAR; PG8_WAIT_L(0); PG8_MMA(0, 0, At, B0); PG8_BAR; PG8_SCHED;
            PG8_LDB(B1, 0, 1); PG8_STAGE(PG8_SB(0, 0), b2, voffB);
            PG8_BAR; PG8_WAIT_L(0); PG8_MMA(0, 1, At, B1); PG8_BAR;
            PG8_LDA(At, 0, 1); PG8_STAGE(PG8_SA(0, 0), a2, voffA);
            PG8_BAR; PG8_WAIT_L(0); PG8_MMA(1, 0, At, B0); PG8_BAR; PG8_SCHED;
            PG8_STAGE(PG8_SB(0, 1), b2 + hstep, voffB);
            PG8_WAIT_V(6); PG8_BAR; PG8_MMA(1, 1, At, B1); PG8_BAR;
            PG8_LDB(B0, 1, 0); PG8_SCHED; PG8_LDA(At, 1, 0); PG8_STAGE(PG8_SA(0, 1), a2 + hstep, voffA);
            PG8_WAIT_L(8); PG8_BAR; PG8_WAIT_L(0); PG8_MMA(0, 0, At, B0); PG8_BAR; PG8_SCHED;
            PG8_LDB(B1, 1, 1); PG8_STAGE(PG8_SB(1, 0), b3, voffB);
            PG8_BAR; PG8_WAIT_L(0); PG8_MMA(0, 1, At, B1); PG8_BAR;
            PG8_LDA(At, 1, 1); PG8_STAGE(PG8_SA(1, 0), a3, voffA);
            PG8_BAR; PG8_WAIT_L(0); PG8_MMA(1, 0, At, B0); PG8_BAR; PG8_SCHED;
            PG8_STAGE(PG8_SB(1, 1), b3 + hstep, voffB);
            PG8_WAIT_V(6); PG8_BAR; PG8_MMA(1, 1, At, B1); PG8_BAR;
        }
        E(acc, cur, wr, wc, fr, fq); S.done(cur);
        if (!has_next) break;
#pragma unroll
        for (int a = 0; a < 2; ++a)
#pragma unroll
            for (int b = 0; b < 2; ++b)
#pragma unroll
                for (int m = 0; m < 4; ++m)
#pragma unroll
                    for (int n = 0; n < 2; ++n) acc[a][b][m][n] = (f32x4){0.f, 0.f, 0.f, 0.f};
        cur = nxt; cA = nA; cB = nB; ++ui;
    }
    PG8_WAIT_V(0);
    if (wr == 0) PG8_BAR;
    PG8_BAR;
#undef PG8_SA
#undef PG8_SB
#undef PG8_STAGE
#undef PG8_LDA
#undef PG8_LDB
#undef PG8_MMA
#undef PG8_WAIT_V
#undef PG8_WAIT_L
#undef PG8_BAR
#undef PG8_SCHED
}
}

typedef f32x4 AccT[2][2][4][2];

struct EpiIn {
    static constexpr bool PERM = true;
    unsigned short* G; bf16_t* V; bf16_t* Q; bf16_t* GATE; bf16_t* BG; bf16_t* P; const float* lb;
    __device__ __forceinline__ void operator()(const AccT& acc, const pg8::Unit& u, int wr, int wc, int fr, int fq) const {
        const int row0 = u.pm * 256 + wr * 64 + fr, cl = wc * 32 + 8 * fq, pn = u.pn;
        if (pn < 8) {
#pragma unroll
            for (int bj = 0; bj < 2; ++bj) {
                const int col = pn * 256 + bj * 128 + cl;
                const f32x4 l0 = *(const f32x4*)(lb + col), l1 = *(const f32x4*)(lb + col + 4);
#pragma unroll
                for (int ai = 0; ai < 2; ++ai)
#pragma unroll
                    for (int m = 0; m < 4; ++m) {
                        const f32x4 a = acc[ai][bj][m][0], b = acc[ai][bj][m][1]; float g[8];
#pragma unroll
                        for (int j = 0; j < 4; ++j) { g[j] = (1.f - l0[j]) * __builtin_amdgcn_rcpf(1.f + __expf(a[j])); g[4 + j] = (1.f - l1[j]) * __builtin_amdgcn_rcpf(1.f + __expf(b[j])); }
                        u32x4 w; w.x = pk_h2(g[0], g[1]); w.y = pk_h2(g[2], g[3]); w.z = pk_h2(g[4], g[5]); w.w = pk_h2(g[6], g[7]);
                        *(u32x4*)(G + (size_t)(row0 + ai * 128 + m * 16) * 2048 + col) = w;
                    }
            }
        } else if (pn < 24) {
            if (u.pm >= 128 && pn >= 12) return;
            const int ty = (pn - 8) >> 2; bf16_t* base = V + (ty == 0 ? (size_t)0 : (size_t)TALL * HW + (size_t)(ty - 1) * T * HW);
            const bool act = (ty == 1);
            const int colt = (pn - 8 - 4 * ty) * 256;
#pragma unroll
            for (int ai = 0; ai < 2; ++ai)
#pragma unroll
                for (int m = 0; m < 4; ++m)
#pragma unroll
                    for (int bj = 0; bj < 2; ++bj) {
                        f32x4 a = acc[ai][bj][m][0], b = acc[ai][bj][m][1];
                        if (act) {
#pragma unroll
                            for (int j = 0; j < 4; ++j) { a[j] = silu_f(a[j]); b[j] = silu_f(b[j]); } }
                        u32x4 w; w.x = cvt_pk_bf16(a[0], a[1]); w.y = cvt_pk_bf16(a[2], a[3]); w.z = cvt_pk_bf16(b[0], b[1]); w.w = cvt_pk_bf16(b[2], b[3]);
                        *(u32x4*)(base + (size_t)(row0 + ai * 128 + m * 16) * 1024 + colt + bj * 128 + cl) = w;
                    }
        } else {
            if (u.pm >= 128) return;
            const int col = (pn - 24) * 128 + cl;
#pragma unroll
            for (int ai = 0; ai < 2; ++ai)
#pragma unroll
                for (int m = 0; m < 4; ++m) {
                    const f32x4 a = acc[ai][0][m][0] * acc[ai][1][m][0], b = acc[ai][0][m][1] * acc[ai][1][m][1];
                    u32x4 w; w.x = cvt_pk_bf16(a[0], a[1]); w.y = cvt_pk_bf16(a[2], a[3]); w.z = cvt_pk_bf16(b[0], b[1]); w.w = cvt_pk_bf16(b[2], b[3]);
                    *(u32x4*)(P + (size_t)(row0 + ai * 128 + m * 16) * 1024 + col) = w;
                }
        }
    }
};
struct EpiOut {
    static constexpr bool PERM = true;
    const float* x; const float* mod; unsigned short* U1;
    __device__ __forceinline__ void operator()(const AccT& acc, const pg8::Unit& u, int wr, int wc, int fr, int fq) const {
        const int row0 = u.pm * 256 + wr * 64 + fr, col0 = u.pn * 256 + wc * 32 + 8 * fq;
        const float* ga = mod + (u.pm >= 64 ? 12288 : 0) + 2 * 2048;
        f32x4 gv[2][2];
#pragma unroll
        for (int bj = 0; bj < 2; ++bj)
#pragma unroll
            for (int n = 0; n < 2; ++n) gv[bj][n] = *(const f32x4*)(ga + col0 + bj * 128 + n * 4);
#pragma unroll
        for (int ai = 0; ai < 2; ++ai) {
            f32x4 xa[4][2], xb[4][2];
#pragma unroll
            for (int m = 0; m < 4; ++m) { const size_t off = (size_t)(row0 + ai * 128 + m * 16) * D + col0;
#pragma unroll
                for (int bj = 0; bj < 2; ++bj) { xa[m][bj] = *(const f32x4*)(x + off + bj * 128); xb[m][bj] = *(const f32x4*)(x + off + bj * 128 + 4); } }
#pragma unroll
            for (int m = 0; m < 4; ++m) { const size_t off = (size_t)(row0 + ai * 128 + m * 16) * D + col0;
#pragma unroll
                for (int bj = 0; bj < 2; ++bj) {
                    const f32x4 a = ALPHA * xa[m][bj] + gv[bj][0] * acc[ai][bj][m][0], b = ALPHA * xb[m][bj] + gv[bj][1] * acc[ai][bj][m][1];
                    u32x4 w; w.x = pk_h2(a[0], a[1]); w.y = pk_h2(a[2], a[3]); w.z = pk_h2(b[0], b[1]); w.w = pk_h2(b[2], b[3]);
                    *(u32x4*)(U1 + off + bj * 128) = w; } }
        }
    }
};
struct EpiGU {
    static constexpr bool PERM = true;
    bf16_t* HID;
    __device__ __forceinline__ void operator()(const AccT& acc, const pg8::Unit& u, int wr, int wc, int fr, int fq) const {
        const int row0 = u.pm * 256 + wr * 64 + fr, col = u.pn * 128 + wc * 32 + 8 * fq;
#pragma unroll
        for (int ai = 0; ai < 2; ++ai)
#pragma unroll
            for (int m = 0; m < 4; ++m) {
                f32x4 a = acc[ai][0][m][0], b = acc[ai][0][m][1];
#pragma unroll
                for (int j = 0; j < 4; ++j) { a[j] = silu_f(a[j]) * acc[ai][1][m][0][j]; b[j] = silu_f(b[j]) * acc[ai][1][m][1][j]; }
                u32x4 w; w.x = cvt_pk_bf16(a[0], a[1]); w.y = cvt_pk_bf16(a[2], a[3]); w.z = cvt_pk_bf16(b[0], b[1]); w.w = cvt_pk_bf16(b[2], b[3]);
                *(u32x4*)(HID + (size_t)(row0 + ai * 128 + m * 16) * DFF + col) = w;
            }
    }
};
struct EpiDown {
    static constexpr bool PERM = true;
    const unsigned short* U1; const float* stats; const float* mod; const float* g1; const float* b1; unsigned short* U2;
    __device__ __forceinline__ void operator()(const AccT& acc, const pg8::Unit& u, int wr, int wc, int fr, int fq) const {
        const int row0 = u.pm * 256 + wr * 64 + fr, col0 = u.pn * 256 + wc * 32 + 8 * fq;
        const float* ga = mod + (u.pm >= 64 ? 12288 : 0) + 5 * 2048;
        f32x4 gv[2][2], lg[2][2], lbv[2][2];
#pragma unroll
        for (int bj = 0; bj < 2; ++bj)
#pragma unroll
            for (int n = 0; n < 2; ++n) { const int c = col0 + bj * 128 + n * 4; gv[bj][n] = *(const f32x4*)(ga + c); lg[bj][n] = ALPHA * *(const f32x4*)(g1 + c); lbv[bj][n] = ALPHA * *(const f32x4*)(b1 + c); }
#pragma unroll
        for (int ai = 0; ai < 2; ++ai) {
            u32x4 uraw[4][2]; f32x2 stv[4];
#pragma unroll
            for (int m = 0; m < 4; ++m) { const int row = row0 + ai * 128 + m * 16; const size_t off = (size_t)row * D + col0; stv[m] = *(const f32x2*)(stats + 2 * row);
#pragma unroll
                for (int bj = 0; bj < 2; ++bj) uraw[m][bj] = *(const u32x4*)(U1 + off + bj * 128); }
#pragma unroll
            for (int m = 0; m < 4; ++m) { const int row = row0 + ai * 128 + m * 16; const size_t off = (size_t)row * D + col0; const f32x2 st = stv[m];
#pragma unroll
                for (int bj = 0; bj < 2; ++bj) { float uf[8]; unpack_h8(uraw[m][bj], uf);
                    const f32x4 ua = {uf[0], uf[1], uf[2], uf[3]}, ub = {uf[4], uf[5], uf[6], uf[7]};
                    const f32x4 a = ((ua - st.x) * st.y) * lg[bj][0] + lbv[bj][0] + gv[bj][0] * acc[ai][bj][m][0], b = ((ub - st.x) * st.y) * lg[bj][1] + lbv[bj][1] + gv[bj][1] * acc[ai][bj][m][1];
                    u32x4 w; w.x = pk_h2(a[0], a[1]); w.y = pk_h2(a[2], a[3]); w.z = pk_h2(b[0], b[1]); w.w = pk_h2(b[2], b[3]);
                    *(u32x4*)(U2 + off + bj * 128) = w; } }
        }
    }
};
#define XB_TMO      128
#define XB_XCNT(j)  (256  + 64 * (j))
#define XB_XSUB(j)  (1280 + 64 * (j))
#define XB_XGEN(j)  (2304 + 64 * (j))
#define XB_TOP      3328
#define XB_TOPGEN   3392
#define XCD_BAR_WORDS 3456
#define XB_SPIN_CAP (1u << 18)
__device__ __forceinline__ unsigned xb_ld(unsigned* p)              { return __hip_atomic_load(p, __ATOMIC_RELAXED, __HIP_MEMORY_SCOPE_AGENT); }
__device__ __forceinline__ unsigned xb_add(unsigned* p, unsigned v) { return __hip_atomic_fetch_add(p, v, __ATOMIC_RELAXED, __HIP_MEMORY_SCOPE_AGENT); }
__device__ __forceinline__ unsigned xb_xcc_id() { return (unsigned)__builtin_amdgcn_s_getreg((3 << 11) | 20) & 0xFu; }
#define XB_SPIN(cond, bar) do { unsigned _sp = 0; while (cond) { __builtin_amdgcn_s_sleep(1); \
    if ((++_sp & 255u) == 0u) { if (xb_ld(&(bar)[XB_TMO])) break; if (_sp > XB_SPIN_CAP) { atomicAdd(&(bar)[XB_TMO], 1u); break; } } } } while (0)
struct XcdBarrier { unsigned* bar; unsigned x; volatile PG8_LAS unsigned* st; };
__device__ __forceinline__ XcdBarrier xcd_barrier_post(unsigned* bar, volatile PG8_LAS unsigned* st) {
    XcdBarrier b; b.bar = bar; b.x = xb_xcc_id(); b.st = st;
    if (threadIdx.x == 0) (void)xb_add(&bar[XB_XCNT(b.x)], 1u);
    return b;
}
__device__ __forceinline__ void xcd_barrier_complete(unsigned* bar, unsigned x, unsigned& nloc, unsigned& nx) {
    const unsigned G = gridDim.x * gridDim.y * gridDim.z;
    unsigned sum, cnt, mine, sp = 0u;
    for (;;) {
        sum = 0u; cnt = 0u; mine = 0u;
#pragma unroll
        for (unsigned j = 0; j < 16; ++j) { const unsigned c = xb_ld(&bar[XB_XCNT(j)]); sum += c; cnt += (c > 0u) ? 1u : 0u; mine = (j == x) ? c : mine; }
        if (sum == G) break;
        __builtin_amdgcn_s_sleep(1);
        if ((++sp & 255u) == 0u) { if (xb_ld(&bar[XB_TMO])) break; if (sp > XB_SPIN_CAP) { atomicAdd(&bar[XB_TMO], 1u); break; } }
    }
    nloc = mine > 0u ? mine : 1u; nx = cnt > 0u ? cnt : 1u;
}
__device__ __forceinline__ void xcd_barrier(const XcdBarrier& b) {
    asm volatile("s_waitcnt vmcnt(0)" ::: "memory");
    __syncthreads();
    if (threadIdx.x == 0) {
        unsigned* bar = b.bar;
        __builtin_amdgcn_s_waitcnt(0);
        unsigned nloc = b.st[0], nx = b.st[1];
        if (nloc == 0u) { xcd_barrier_complete(bar, b.x, nloc, nx); b.st[0] = nloc; b.st[1] = nx; }
        const unsigned old = xb_add(&bar[XB_XSUB(b.x)], 1u);
        const unsigned gen = old / nloc;
        if (old + 1u == (gen + 1u) * nloc) {
            __builtin_amdgcn_fence(__ATOMIC_RELEASE, "agent");
            asm volatile("s_waitcnt vmcnt(0)" ::: "memory");
            const unsigned og = xb_add(&bar[XB_TOP], 1u);
            const unsigned tg = og / nx;
            if (og + 1u == (tg + 1u) * nx) xb_add(&bar[XB_TOPGEN], 1u);
            else XB_SPIN(xb_ld(&bar[XB_TOPGEN]) == tg, bar);
            __builtin_amdgcn_fence(__ATOMIC_ACQUIRE, "agent");
            xb_add(&bar[XB_XGEN(b.x)], 1u);
            asm volatile("s_waitcnt vmcnt(0)" ::: "memory");
        } else {
            XB_SPIN(xb_ld(&bar[XB_XGEN(b.x)]) == gen, bar);
            __builtin_amdgcn_fence(__ATOMIC_ACQUIRE, "agent");
            asm volatile("s_waitcnt vmcnt(0)" ::: "memory");
        }
    }
    __syncthreads();
}

struct OneUnit {
    int pm, pn;
    __device__ __forceinline__ bool next(int i, pg8::Unit& u) const { if (i != 0) return false; u.pm = pm; u.pn = pn; return true; }
    __device__ __forceinline__ void a_ready(const pg8::Unit&) const {}
    __device__ __forceinline__ void done(const pg8::Unit&) const {}
};

struct Params {
    const float *x, *c, *ctx, *cctx, *w_mod, *b_mod, *w_in, *lb_logits, *g_norm_w, *conv_w, *w_out, *ln1_g, *ln1_b, *w_gate, *w_up, *w_down, *ln2_g, *ln2_b;
    float* out; unsigned char* ws; int lo, hi;
};

__device__ __forceinline__ void transpose_item(const float* W, int N, bf16_t* WT, int K, int k0, int n0, int dest_row0, float*  , int lane) {
    typedef unsigned u32x2s __attribute__((ext_vector_type(2)));
    float tv[32];
#pragma unroll
    for (int i = 0; i < 32; ++i) tv[i] = W[(size_t)(k0 + 2 * i + (lane >> 5)) * N + n0 + (lane & 31)];
    unsigned pk[16];
#pragma unroll
    for (int i = 0; i < 16; ++i) {
        const u32x2s r = __builtin_amdgcn_permlane32_swap(__float_as_uint(tv[i]), __float_as_uint(tv[i + 16]), false, false);
        pk[i] = cvt_pk_bf16(__uint_as_float(r.x), __uint_as_float(r.y));
    }
    bf16_t* dst = WT + (size_t)(dest_row0 + (lane & 31)) * K + k0 + (lane >> 5) * 32;
#pragma unroll
    for (int j = 0; j < 4; ++j) *(u32x4*)(dst + 8 * j) = (u32x4){pk[4 * j], pk[4 * j + 1], pk[4 * j + 2], pk[4 * j + 3]};
}

__device__ __forceinline__ void phase_prep(const Params& p, unsigned char* lds) {
    const int tid = threadIdx.x, lane = tid & 63, wave = tid >> 6;
    float* modv = (float*)(p.ws + WS_MOD);
    {
        float* sc = (float*)lds;
        float* red = (float*)(lds + 24576);
        for (int i = tid; i < 3 * 2048; i += 512) { const int o = i >> 11, k = i & 2047; const float v = o == 0 ? p.c[k] : o == 1 ? p.c[2048 + k] : p.cctx[k]; sc[i] = silu_f(v); }
        __syncthreads();
        for (int item = blockIdx.x; item < 256; item += gridDim.x) {
            const int col0 = item * 48, kq = tid / 12, c4 = tid % 12;
            f32x4 a0 = {0, 0, 0, 0}, a1 = {0, 0, 0, 0}, a2 = {0, 0, 0, 0};
            if (kq < 42) {
#pragma unroll 7
                for (int k = kq; k < 2048; k += 42) {
                    const f32x4 w = *(const f32x4*)(p.w_mod + (size_t)k * 12288 + col0 + 4 * c4);
                    a0 += sc[k] * w; a1 += sc[2048 + k] * w; a2 += sc[4096 + k] * w;
                }
                float* r = red + (kq * 12 + c4) * 12;
                *(f32x4*)(r) = a0; *(f32x4*)(r + 4) = a1; *(f32x4*)(r + 8) = a2;
            }
            __syncthreads();
            if (tid < 144) { const int o = tid / 48, cc = tid % 48; float s = 0.f;
                for (int q = 0; q < 42; ++q) s += red[(q * 12 + (cc >> 2)) * 12 + o * 4 + (cc & 3)];
                modv[o * 12288 + col0 + cc] = s + p.b_mod[col0 + cc]; }
            __syncthreads();
        }
    }
    if (blockIdx.x < 4) { const int idx = blockIdx.x * 512 + tid, dir = idx >> 10, ch = idx & 1023;
        const float a0 = p.lb_logits[dir * 2048 + ch], a1 = p.lb_logits[dir * 2048 + 1024 + ch];
        ((float*)(p.ws + WS_LB))[idx] = 1.f / (1.f + __expf(a1 - a0)); }
    {
        const int gw = blockIdx.x * 8 + wave, NGW = gridDim.x * 8;
        constexpr int I_IN = 32 * 256, I_OUT = 32 * 64, I_G = 32 * 176, I_D = 88 * 64;
        constexpr int NITEMS = I_IN + I_OUT + 2 * I_G + I_D;
        bf16_t* Win = (bf16_t*)(p.ws + WS_WIN); bf16_t* Wout = (bf16_t*)(p.ws + WS_WOUT); bf16_t* Wgu = (bf16_t*)(p.ws + WS_WGU); bf16_t* Wdn = (bf16_t*)(p.ws + WS_WDN);
        typedef unsigned u32x2s __attribute__((ext_vector_type(2)));
        for (int it0 = gw; it0 < NITEMS; it0 += 2 * NGW) {
            const float* src[2]; bf16_t* dstp[2]; int srcN[2]; bool valid[2];
#pragma unroll
            for (int u = 0; u < 2; ++u) {
                int r = it0 + u * NGW; valid[u] = r < NITEMS; if (!valid[u]) r = it0;
                const float* W; int N, K, k0, n0, drow; bf16_t* WT;
                if (r < I_IN) { const int kb = r / 256, nb = r % 256; n0 = nb * 32; drow = n0;
                    if (n0 >= 6144) { const int isx = n0 >= 7168, j = n0 - (isx ? 7168 : 6144); drow = 6144 + 256 * (j >> 7) + 128 * isx + (j & 127); }
                    W = p.w_in; N = NIN; WT = Win; K = D; k0 = kb * 64; }
                else if (r < I_IN + I_OUT) { r -= I_IN; const int kb = r / 64, nb = r % 64; W = p.w_out; N = D; WT = Wout; K = D; k0 = kb * 64; n0 = nb * 32; drow = n0; }
                else if (r < I_IN + I_OUT + I_G) { r -= I_IN + I_OUT; const int kb = r / 176, nb = r % 176; n0 = nb * 32; W = p.w_gate; N = DFF; WT = Wgu; K = D; k0 = kb * 64; drow = 256 * (n0 >> 7) + (n0 & 127); }
                else if (r < I_IN + I_OUT + 2 * I_G) { r -= I_IN + I_OUT + I_G; const int kb = r / 176, nb = r % 176; n0 = nb * 32; W = p.w_up; N = DFF; WT = Wgu; K = D; k0 = kb * 64; drow = 256 * (n0 >> 7) + 128 + (n0 & 127); }
                else { r -= I_IN + I_OUT + 2 * I_G; const int kb = r / 64, nb = r % 64; W = p.w_down; N = D; WT = Wdn; K = DFF; k0 = kb * 64; n0 = nb * 32; drow = n0; }
                src[u] = W + (size_t)(k0 + (lane >> 5)) * N + n0 + (lane & 31); srcN[u] = N;
                dstp[u] = WT + (size_t)(drow + (lane & 31)) * K + k0 + (lane >> 5) * 32;
            }
            float tv[2][32];
#pragma unroll
            for (int u = 0; u < 2; ++u)
#pragma unroll
                for (int i = 0; i < 32; ++i) tv[u][i] = src[u][(size_t)(2 * i) * srcN[u]];
#pragma unroll
            for (int u = 0; u < 2; ++u) {
                if (!valid[u]) break;
                unsigned pk[16];
#pragma unroll
                for (int i = 0; i < 16; ++i) { const u32x2s rr = __builtin_amdgcn_permlane32_swap(__float_as_uint(tv[u][i]), __float_as_uint(tv[u][i + 16]), false, false);
                    pk[i] = cvt_pk_bf16(__uint_as_float(rr.x), __uint_as_float(rr.y)); }
#pragma unroll
                for (int j = 0; j < 4; ++j) *(u32x4*)(dstp[u] + 8 * j) = (u32x4){pk[4 * j], pk[4 * j + 1], pk[4 * j + 2], pk[4 * j + 3]};
            }
        }
    }
}

__device__ __forceinline__ void ln_ctx_rows(const Params& p, int row_lo, int nrows) {
    const int lane = threadIdx.x & 63, wave = threadIdx.x >> 6;
    const float* mv = (const float*)(p.ws + WS_MOD) + 24576; bf16_t* H = (bf16_t*)(p.ws + WS_H);
    for (int r0 = 4 * wave; r0 < nrows; r0 += 32) {
        f32x4 v[4][8]; float rstd[4];
#pragma unroll
        for (int r = 0; r < 4; ++r) { const f32x4* xr = (const f32x4*)(p.ctx + (size_t)(row_lo - T + r0 + r) * D) + lane;
#pragma unroll
            for (int j = 0; j < 8; ++j) v[r][j] = xr[64 * j]; }
#pragma unroll
        for (int r = 0; r < 4; ++r) { float s = 0.f;
#pragma unroll
            for (int j = 0; j < 8; ++j) s += (v[r][j].x + v[r][j].y) + (v[r][j].z + v[r][j].w);
            const float mean = wave_sum(s) * (1.f / D); float s2 = 0.f;
#pragma unroll
            for (int j = 0; j < 8; ++j) { v[r][j] = v[r][j] - mean; s2 += (v[r][j].x * v[r][j].x + v[r][j].y * v[r][j].y) + (v[r][j].z * v[r][j].z + v[r][j].w * v[r][j].w); }
            rstd[r] = 1.f / sqrtf(wave_sum(s2) * (1.f / D) + LN_EPS); }
#pragma unroll
        for (int r = 0; r < 4; ++r) { u32x2* o8 = (u32x2*)(H + (size_t)(row_lo + r0 + r) * D) + lane;
#pragma unroll
            for (int j = 0; j < 8; ++j) { const f32x4 sh = *((const f32x4*)mv + lane + 64 * j), sc = *((const f32x4*)(mv + 2048) + lane + 64 * j);
                const f32x4 h = (v[r][j] * rstd[r]) * (1.f + sc) + sh; u32x2 w; w.x = cvt_pk_bf16(h.x, h.y); w.y = cvt_pk_bf16(h.z, h.w); o8[64 * j] = w; } }
    }
}
__device__ __forceinline__ void phase_ln_in(const Params& p, int row_lo, int row_hi, int gw, int NGW) {
    const int lane = threadIdx.x & 63;
    const float* modv = (const float*)(p.ws + WS_MOD); bf16_t* H = (bf16_t*)(p.ws + WS_H);
    f32x4 SHv[8], SCv[8]; int curm = -1;
#pragma unroll
    for (int j = 0; j < 8; ++j) { SHv[j] = (f32x4){0.f, 0.f, 0.f, 0.f}; SCv[j] = SHv[j]; }
    for (int rowa = row_lo + gw; rowa < row_hi; rowa += 2 * NGW) {
      const int rowb = (rowa + NGW < row_hi) ? rowa + NGW : rowa;
      f32x4 va[8], vb[8];
#pragma unroll
      for (int j = 0; j < 8; ++j) { va[j] = ((const f32x4*)(rowa < T ? p.x + (size_t)rowa * D : p.ctx + (size_t)(rowa - T) * D) + lane)[64 * j];
                                    vb[j] = ((const f32x4*)(rowb < T ? p.x + (size_t)rowb * D : p.ctx + (size_t)(rowb - T) * D) + lane)[64 * j]; }
#pragma unroll
      for (int r = 0; r < 2; ++r) {
        if (r == 1 && rowb == rowa) break;
        const int row = r == 0 ? rowa : rowb;
        const int mrow = row < SEQ ? 0 : row < T ? 1 : 2;
        if (mrow != curm) { curm = mrow; const float* mv = modv + mrow * 12288;
#pragma unroll
            for (int j = 0; j < 8; ++j) { SHv[j] = *((const f32x4*)mv + lane + 64 * j); SCv[j] = 1.f + *((const f32x4*)(mv + 2048) + lane + 64 * j); } }
        f32x4 v[8]; float s = 0.f;
#pragma unroll
        for (int j = 0; j < 8; ++j) { v[j] = r == 0 ? va[j] : vb[j]; s += (v[j].x + v[j].y) + (v[j].z + v[j].w); }
        const float mean = wave_sum(s) * (1.f / D); float s2 = 0.f;
#pragma unroll
        for (int j = 0; j < 8; ++j) { v[j] = v[j] - mean; s2 += (v[j].x * v[j].x + v[j].y * v[j].y) + (v[j].z * v[j].z + v[j].w * v[j].w); }
        const float rstd = 1.f / sqrtf(wave_sum(s2) * (1.f / D) + LN_EPS);
        u32x2* o8 = (u32x2*)(H + (size_t)row * D) + lane;
#pragma unroll
        for (int j = 0; j < 8; ++j) { const f32x4 h = (v[j] * rstd) * SCv[j] + SHv[j]; u32x2 w; w.x = cvt_pk_bf16(h.x, h.y); w.y = cvt_pk_bf16(h.z, h.w); o8[64 * j] = w; }
      }
    }
}

constexpr int L_QH = 0, L_KH = 17408, L_KHT = 34816, L_VT = 53248, L_SC = 71680, L_PART = 80896, L_ER = 84992, L_EBR = 85504;
#define MFMA16(a, b, c) __builtin_amdgcn_mfma_f32_16x16x32_bf16(a, b, c, 0, 0, 0)

#define SCAN_LOADB(GK, VV, QQ, c) do { _Pragma("unroll") for (int j = 0; j < 8; ++j) { const size_t row = (size_t)(r0 + rs * (64 * (c) + 8 * w + j)); \
        GK[j] = *(const unsigned*)(Gp + row * 2048 + gcol + 2 * lane); VV[j] = *(const unsigned*)(Vp + row * 1024 + hcol + 2 * lane); if (OUT) QQ[j] = *(const unsigned*)(Qp + row * 1024 + hcol + 2 * lane); } } while (0)
#define SCAN_BAR() do { asm volatile("s_waitcnt lgkmcnt(0)" ::: "memory"); __builtin_amdgcn_s_barrier(); asm volatile("" ::: "memory"); } while (0)
template <bool OUT>
__device__ __forceinline__ void scan_chunk(unsigned char* lds, const unsigned short* Gp, const bf16_t* Vp, const bf16_t* Qp, bf16_t* Op, int r0, int rs, int c, int cpre, int gcol, int hcol,
                                           f32x4 (&S)[8], f32x2& dtot, unsigned (&gk)[8], unsigned (&vv)[8], unsigned (&qq)[8]) {
    const int tid = threadIdx.x, lane = tid & 63, w = __builtin_amdgcn_readfirstlane(tid >> 6), fr = lane & 15, q = lane >> 4;
    float* PART = (float*)(lds + L_PART); float* ER = (float*)(lds + L_ER); float* EBR = (float*)(lds + L_EBR);
    {
        f32x2 kf[8], loc[8]; f32x2 run = {1.f, 1.f};
#pragma unroll
        for (int j = 0; j < 8; ++j) { const h16x2 kk = __builtin_bit_cast(h16x2, gk[j]); kf[j] = (f32x2){(float)kk.x, (float)kk.y}; }
        if (w >= 4) {
#pragma unroll
            for (int j = 0; j < 8; ++j) { run *= 1.f - kf[j]; loc[j] = run; }
        } else {
#pragma unroll
            for (int j = 7; j >= 0; --j) { loc[j] = run; run *= 1.f - kf[j]; }
        }
        *(f32x2*)(PART + w * 128 + 2 * lane) = run;
        SCAN_BAR();
        {
            f32x2 pv[8];
#pragma unroll
            for (int o = 0; o < 8; ++o) pv[o] = *(const f32x2*)(PART + o * 128 + 2 * lane);
            f32x2 fac = {1.f, 1.f};
#pragma unroll
            for (int o = 0; o < 8; ++o) { const bool use = (w >= 4) ? (o >= 4 && o < w) : (o > w && o <= 3); if (use) fac *= pv[o]; }
            f32x2 kh[8];
#pragma unroll
            for (int j = 0; j < 8; ++j) {
                const f32x2 m = loc[j] * fac; const f32x2 inv = {__builtin_amdgcn_rcpf(m.x), __builtin_amdgcn_rcpf(m.y)};
                kh[j] = kf[j] * (w >= 4 ? inv : m);
                if (OUT) {
                    const f32x2 e1 = w >= 4 ? m : inv;
                    const unsigned qp = cvt_pk_bf16(__uint_as_float(qq[j] << 16) * e1.x, __uint_as_float(qq[j] & 0xffff0000u) * e1.y);
                    const int i = 8 * w + j;
                    *(unsigned*)(lds + L_QH + i * 272 + 4 * lane) = qp;
                    *(unsigned*)(lds + L_KH + i * 272 + 4 * lane) = cvt_pk_bf16(kh[j].x, kh[j].y);
                }
            }
            *(u32x4*)(lds + L_KHT + (2 * lane) * 144 + 16 * w) = (u32x4){cvt_pk_bf16(kh[0].x, kh[1].x), cvt_pk_bf16(kh[2].x, kh[3].x), cvt_pk_bf16(kh[4].x, kh[5].x), cvt_pk_bf16(kh[6].x, kh[7].x)};
            *(u32x4*)(lds + L_KHT + (2 * lane + 1) * 144 + 16 * w) = (u32x4){cvt_pk_bf16(kh[0].y, kh[1].y), cvt_pk_bf16(kh[2].y, kh[3].y), cvt_pk_bf16(kh[4].y, kh[5].y), cvt_pk_bf16(kh[6].y, kh[7].y)};
            *(u32x4*)(lds + L_VT + (2 * lane) * 144 + 16 * w) = (u32x4){__builtin_amdgcn_perm(vv[1], vv[0], 0x05040100u), __builtin_amdgcn_perm(vv[3], vv[2], 0x05040100u), __builtin_amdgcn_perm(vv[5], vv[4], 0x05040100u), __builtin_amdgcn_perm(vv[7], vv[6], 0x05040100u)};
            *(u32x4*)(lds + L_VT + (2 * lane + 1) * 144 + 16 * w) = (u32x4){__builtin_amdgcn_perm(vv[1], vv[0], 0x07060302u), __builtin_amdgcn_perm(vv[3], vv[2], 0x07060302u), __builtin_amdgcn_perm(vv[5], vv[4], 0x07060302u), __builtin_amdgcn_perm(vv[7], vv[6], 0x07060302u)};
            if (w == 0) { const f32x2 er = (pv[0] * pv[1]) * (pv[2] * pv[3]), ebr = (pv[4] * pv[5]) * (pv[6] * pv[7]); *(f32x2*)(ER + 2 * lane) = er; *(f32x2*)(EBR + 2 * lane) = ebr;
                dtot += (f32x2){__logf(er.x) + __logf(ebr.x), __logf(er.y) + __logf(ebr.y)}; }
        }
        if (cpre >= 0) SCAN_LOADB(gk, vv, qq, cpre);
        SCAN_BAR();
#pragma unroll
        for (int kt = 0; kt < 8; ++kt) S[kt] *= *(const f32x4*)(ER + 16 * kt + 4 * q);
        f32x4 oacc[4];
        __builtin_amdgcn_s_setprio(1);
        if (OUT) {
            bf16x8 Sb[4];
#pragma unroll
            for (int m = 0; m < 4; ++m) { u32x4 t; t.x = cvt_pk_bf16(S[2 * m][0], S[2 * m][1]); t.y = cvt_pk_bf16(S[2 * m][2], S[2 * m][3]); t.z = cvt_pk_bf16(S[2 * m + 1][0], S[2 * m + 1][1]); t.w = cvt_pk_bf16(S[2 * m + 1][2], S[2 * m + 1][3]);
                Sb[m] = __builtin_bit_cast(bf16x8, t); }
#pragma unroll
            for (int tb = 0; tb < 4; ++tb) { oacc[tb] = (f32x4){0.f, 0.f, 0.f, 0.f};
#pragma unroll
                for (int m = 0; m < 4; ++m) { const unsigned char* qa = lds + L_QH + (16 * tb + fr) * 272 + (32 * m + 4 * q) * 2;
                    const u32x2 lo = *(const u32x2*)qa, hi = *(const u32x2*)(qa + 32);
                    const bf16x8 qf = __builtin_bit_cast(bf16x8, ((u32x4){lo.x, lo.y, hi.x, hi.y}));
                    oacc[tb] = MFMA16(Sb[m], qf, oacc[tb]); } }
            const int tb = w >> 1;
#pragma unroll
            for (int sbi = 0; sbi < 2; ++sbi) { const int sb = 2 * (w & 1) + sbi; f32x4 a = {0.f, 0.f, 0.f, 0.f};
                if (sb <= tb) {
#pragma unroll
                    for (int m = 0; m < 4; ++m) { const bf16x8 ka = *(const bf16x8*)(lds + L_KH + (16 * sb + fr) * 272 + (32 * m + 8 * q) * 2), qb = *(const bf16x8*)(lds + L_QH + (16 * tb + fr) * 272 + (32 * m + 8 * q) * 2);
                        a = MFMA16(ka, qb, a); }
                    const int tabs = 16 * tb + fr, s0 = 16 * sb + 4 * q;
#pragma unroll
                    for (int j = 0; j < 4; ++j) a[j] = (s0 + j <= tabs) ? a[j] : 0.f;
                }
                u32x2 wv; wv.x = cvt_pk_bf16(a[0], a[1]); wv.y = cvt_pk_bf16(a[2], a[3]);
                *(u32x2*)(lds + L_SC + (16 * tb + fr) * 144 + (16 * sb + 4 * q) * 2) = wv; }
            SCAN_BAR();
        }
        bf16x8 Vf[2];
#pragma unroll
        for (int n = 0; n < 2; ++n) Vf[n] = *(const bf16x8*)(lds + L_VT + (16 * w + fr) * 144 + (32 * n + 8 * q) * 2);
        if (OUT) {
#pragma unroll
            for (int tb = 0; tb < 4; ++tb) {
#pragma unroll
                for (int n = 0; n < 2; ++n) { const bf16x8 sf = *(const bf16x8*)(lds + L_SC + (16 * tb + fr) * 144 + (32 * n + 8 * q) * 2); oacc[tb] = MFMA16(Vf[n], sf, oacc[tb]); }
                const size_t row = (size_t)(r0 + rs * (64 * c + 16 * tb + fr));
                u32x2 wv; wv.x = cvt_pk_bf16(oacc[tb][0], oacc[tb][1]); wv.y = cvt_pk_bf16(oacc[tb][2], oacc[tb][3]);
                *(u32x2*)(Op + row * 1024 + hcol + 16 * w + 4 * q) = wv; }
        }
#pragma unroll
        for (int kt = 0; kt < 8; ++kt) {
#pragma unroll
            for (int n = 0; n < 2; ++n) { const bf16x8 kf = *(const bf16x8*)(lds + L_KHT + (16 * kt + fr) * 144 + (32 * n + 8 * q) * 2); S[kt] = MFMA16(kf, Vf[n], S[kt]); }
            S[kt] *= *(const f32x4*)(EBR + 16 * kt + 4 * q); }
        __builtin_amdgcn_s_setprio(0);
    }
}
template <bool OUT>
__device__ __forceinline__ void scan_run(unsigned char* lds, const unsigned short* Gp, const bf16_t* Vp, const bf16_t* Qp, bf16_t* Op,
                                         int r0, int rs, int chunk0, int nchunks, int gcol, int hcol, f32x4 (&S)[8], f32x2& dtot) {
    const int lane = threadIdx.x & 63, w = __builtin_amdgcn_readfirstlane(threadIdx.x >> 6);
    constexpr int GR = OUT ? 2 : 4;
    unsigned gk[GR][8], vv[GR][8], qq[GR][8];
    const int end = chunk0 + nchunks;
#pragma unroll
    for (int g = 0; g < GR; ++g) SCAN_LOADB(gk[g], vv[g], qq[g], chunk0 + g);
    for (int c = chunk0; c < end; c += GR) {
#pragma unroll
        for (int g = 0; g < GR; ++g) scan_chunk<OUT>(lds, Gp, Vp, Qp, Op, r0, rs, c + g, (c + g + GR < end) ? c + g + GR : -1, gcol, hcol, S, dtot, gk[g], vv[g], qq[g]);
    }
    __syncthreads();
}
#undef SCAN_LOADB
#undef SCAN_BAR

__device__ __forceinline__ void phase_scan1(const Params& p, unsigned char* lds) {
    const int tid = threadIdx.x, lane = tid & 63, w = tid >> 6;
    const unsigned short* Gp = (const unsigned short*)(p.ws + WS_G); const bf16_t* Vp = (const bf16_t*)(p.ws + WS_V);
    for (int item = blockIdx.x; item < 256; item += gridDim.x) {
        const int seq = item >> 3, seg = item & 7, dir = seq >> 4, b = (seq >> 3) & 1, h = seq & 7;
        f32x4 S[8];
#pragma unroll
        for (int kt = 0; kt < 8; ++kt) S[kt] = (f32x4){0.f, 0.f, 0.f, 0.f};
        f32x2 dtot = {0.f, 0.f};
        if (seg < 7) scan_run<false>(lds, Gp, Vp, nullptr, nullptr, dir ? b * SEQ + SEQ - 1 : b * SEQ, dir ? -1 : 1, seg * 32, 32, dir * 1024 + h * 128, h * 128, S, dtot);
        else scan_run<false>(lds, Gp, Vp, nullptr, nullptr, dir ? T + b * CTXL + CTXL - 1 : T + b * CTXL, dir ? -1 : 1, 0, 4, dir * 1024 + h * 128, h * 128, S, dtot);
        float* dst = (float*)(p.ws + WS_SEG) + ((size_t)(seq * 8 + seg) * 8 + w) * 2048;
#pragma unroll
        for (int kt = 0; kt < 8; ++kt)
#pragma unroll
            for (int j = 0; j < 4; ++j) dst[(kt * 4 + j) * 64 + lane] = S[kt][j];
        if (w == 0) *(f32x2*)((float*)(p.ws + WS_SEGDEC) + (seq * 8 + seg) * 128 + 2 * lane) = dtot;
    }
}
__device__ __forceinline__ void phase_scan2(const Params& p, unsigned char* lds) {
    const int tid = threadIdx.x, lane = tid & 63, w = tid >> 6, q = lane >> 4;
    const unsigned short* Gp = (const unsigned short*)(p.ws + WS_G); const bf16_t* Vp = (const bf16_t*)(p.ws + WS_V); const bf16_t* Qp = (const bf16_t*)(p.ws + WS_Q);
    for (int item = blockIdx.x; item < 256; item += gridDim.x) {
        const int seq = item >> 3, seg = item & 7, dir = seq >> 4, b = (seq >> 3) & 1, h = seq & 7;
        f32x4 S[8];
        const float* segb = (const float*)(p.ws + WS_SEG) + ((size_t)(seq * 8) * 8 + w) * 2048; const float* decb = (const float*)(p.ws + WS_SEGDEC) + (seq * 8) * 128;
#pragma unroll
        for (int kt = 0; kt < 8; ++kt)
#pragma unroll
            for (int j = 0; j < 4; ++j) S[kt][j] = segb[(size_t)7 * 8 * 2048 + (kt * 4 + j) * 64 + lane];
        int s = 0;
        for (; s + 1 < seg; s += 2) {
            f32x4 La[8], Lb[8], Da[8], Db[8];
#pragma unroll
            for (int kt = 0; kt < 8; ++kt) { Da[kt] = *(const f32x4*)(decb + s * 128 + 16 * kt + 4 * q); Db[kt] = *(const f32x4*)(decb + (s + 1) * 128 + 16 * kt + 4 * q);
#pragma unroll
                for (int j = 0; j < 4; ++j) { La[kt][j] = segb[(size_t)s * 8 * 2048 + (kt * 4 + j) * 64 + lane]; Lb[kt][j] = segb[(size_t)(s + 1) * 8 * 2048 + (kt * 4 + j) * 64 + lane]; } }
#pragma unroll
            for (int kt = 0; kt < 8; ++kt)
#pragma unroll
                for (int j = 0; j < 4; ++j) S[kt][j] = __expf(Db[kt][j]) * (__expf(Da[kt][j]) * S[kt][j] + La[kt][j]) + Lb[kt][j];
        }
        if (s < seg) {
#pragma unroll
            for (int kt = 0; kt < 8; ++kt)
#pragma unroll
                for (int j = 0; j < 4; ++j) S[kt][j] = __expf(decb[s * 128 + 16 * kt + 4 * q + j]) * S[kt][j] + segb[(size_t)s * 8 * 2048 + (kt * 4 + j) * 64 + lane];
        }
        f32x2 dtot = {0.f, 0.f};
        bf16_t* Op = (bf16_t*)(p.ws + WS_O) + (size_t)dir * T * HW;
        scan_run<true>(lds, Gp, Vp, Qp, Op, dir ? b * SEQ + SEQ - 1 : b * SEQ, dir ? -1 : 1, seg * 32, 32, dir * 1024 + h * 128, h * 128, S, dtot);
    }
}

__device__ __forceinline__ void phase_combine(const Params& p) {
    const int lane = threadIdx.x & 63, gw = blockIdx.x * 8 + (threadIdx.x >> 6), NGW = gridDim.x * 8;
    const bf16_t* Of = (const bf16_t*)(p.ws + WS_O); const bf16_t* Ob = Of + (size_t)T * HW; const bf16_t* GT = (const bf16_t*)(p.ws + WS_GATE);
    const bf16_t* BG = (const bf16_t*)(p.ws + WS_BG); const bf16_t* P = (const bf16_t*)(p.ws + WS_P); bf16_t* Y = (bf16_t*)(p.ws + WS_Y);
    const int c0 = 16 * lane;
    {
        float gw_[16];
#pragma unroll
        for (int j = 0; j < 16; ++j) gw_[j] = p.g_norm_w[(c0 + j) & 127];
        u32x4 a[2][2], b[2][2], g[2][2], na[2][2], nb[2][2], ng[2][2];
#define HG_LOAD(A_, B_, G_, tk0) do { _Pragma("unroll") for (int u = 0; u < 2; ++u) { const int tk_ = ((tk0) + u * NGW < T) ? (tk0) + u * NGW : gw; \
            _Pragma("unroll") for (int i = 0; i < 2; ++i) { const size_t off = (size_t)tk_ * 1024 + c0 + 8 * i; A_[u][i] = *(const u32x4*)(Of + off); B_[u][i] = *(const u32x4*)(Ob + off); G_[u][i] = *(const u32x4*)(GT + off); } } } while (0)
        HG_LOAD(a, b, g, gw);
#pragma unroll
        for (int u = 0; u < 2; ++u)
#pragma unroll
            for (int i = 0; i < 2; ++i) { na[u][i] = a[u][i]; nb[u][i] = b[u][i]; ng[u][i] = g[u][i]; }
        for (int tok0 = gw; tok0 < T; tok0 += 2 * NGW) {
            if (tok0 + 2 * NGW < T) HG_LOAD(na, nb, ng, tok0 + 2 * NGW);
#pragma unroll
            for (int u = 0; u < 2; ++u) {
                const int tok = tok0 + u * NGW; if (tok >= T) break;
                float o[16], gt[16]; float ss = 0.f;
#pragma unroll
                for (int i = 0; i < 2; ++i)
#pragma unroll
                    for (int j = 0; j < 4; ++j) { const unsigned ua = a[u][i][j], ub = b[u][i][j], ug = g[u][i][j];
                        const float lo = __uint_as_float(ua << 16) + __uint_as_float(ub << 16), hi = __uint_as_float(ua & 0xffff0000u) + __uint_as_float(ub & 0xffff0000u);
                        o[8 * i + 2 * j] = lo; o[8 * i + 2 * j + 1] = hi; ss += lo * lo + hi * hi; gt[8 * i + 2 * j] = silu_f(__uint_as_float(ug << 16)); gt[8 * i + 2 * j + 1] = silu_f(__uint_as_float(ug & 0xffff0000u)); }
                ss += __shfl_xor(ss, 1); ss += __shfl_xor(ss, 2); ss += __shfl_xor(ss, 4);
                const float rstd = 1.f / sqrtf(ss * (1.f / 128.f) + RMS_EPS);
                u32x4 w[2];
#pragma unroll
                for (int i = 0; i < 2; ++i)
#pragma unroll
                    for (int j = 0; j < 4; ++j) w[i][j] = cvt_pk_bf16(o[8 * i + 2 * j] * rstd * gw_[8 * i + 2 * j] * gt[8 * i + 2 * j], o[8 * i + 2 * j + 1] * rstd * gw_[8 * i + 2 * j + 1] * gt[8 * i + 2 * j + 1]);
                bf16_t* yr = Y + (size_t)tok * D + c0;
                *(u32x4*)yr = w[0]; *(u32x4*)(yr + 8) = w[1];
            }
#pragma unroll
            for (int u = 0; u < 2; ++u)
#pragma unroll
                for (int i = 0; i < 2; ++i) { a[u][i] = na[u][i]; b[u][i] = nb[u][i]; g[u][i] = ng[u][i]; }
        }
#undef HG_LOAD
    }
    {
        float cw0[16], cw1[16], cw2[16];
#pragma unroll
        for (int j = 0; j < 16; ++j) { cw0[j] = p.conv_w[c0 + j]; cw1[j] = p.conv_w[1024 + c0 + j]; cw2[j] = p.conv_w[2048 + c0 + j]; }
        u32x4 pc[2][2], pp[2][2], pn[2][2], bg[2][2], npc[2][2], npp[2][2], npn[2][2], nbg[2][2];
#define CONV_LOAD(tk0, PC, PP, PN, BGv) do { _Pragma("unroll") for (int u = 0; u < 2; ++u) { const int tk_ = ((tk0) + u * NGW < T) ? (tk0) + u * NGW : gw; \
            const int tt_ = tk_ & 63; const bool hp_ = tt_ != 0, hn_ = tt_ != 63; _Pragma("unroll") for (int i = 0; i < 2; ++i) { const size_t off = (size_t)tk_ * 1024 + c0 + 8 * i; \
            PC[u][i] = *(const u32x4*)(P + off); BGv[u][i] = *(const u32x4*)(BG + off); PP[u][i] = hp_ ? *(const u32x4*)(P + off - 1024) : (u32x4){0, 0, 0, 0}; PN[u][i] = hn_ ? *(const u32x4*)(P + off + 1024) : (u32x4){0, 0, 0, 0}; } } } while (0)
        CONV_LOAD(gw, pc, pp, pn, bg);
#pragma unroll
        for (int u = 0; u < 2; ++u)
#pragma unroll
            for (int i = 0; i < 2; ++i) { npc[u][i] = pc[u][i]; npp[u][i] = pp[u][i]; npn[u][i] = pn[u][i]; nbg[u][i] = bg[u][i]; }
        for (int tok0 = gw; tok0 < T; tok0 += 2 * NGW) {
            if (tok0 + 2 * NGW < T) CONV_LOAD(tok0 + 2 * NGW, npc, npp, npn, nbg);
#pragma unroll
            for (int u = 0; u < 2; ++u) {
                const int tok = tok0 + u * NGW; if (tok >= T) break;
                u32x4 w[2];
#pragma unroll
                for (int i = 0; i < 2; ++i)
#pragma unroll
                    for (int j = 0; j < 4; ++j) { const int e = 8 * i + 2 * j;
                        const float lo = __uint_as_float(bg[u][i][j] << 16) * (cw0[e] * __uint_as_float(pp[u][i][j] << 16) + cw1[e] * __uint_as_float(pc[u][i][j] << 16) + cw2[e] * __uint_as_float(pn[u][i][j] << 16));
                        const float hi = __uint_as_float(bg[u][i][j] & 0xffff0000u) * (cw0[e + 1] * __uint_as_float(pp[u][i][j] & 0xffff0000u) + cw1[e + 1] * __uint_as_float(pc[u][i][j] & 0xffff0000u) + cw2[e + 1] * __uint_as_float(pn[u][i][j] & 0xffff0000u));
                        w[i][j] = cvt_pk_bf16(lo, hi); }
                bf16_t* yr = Y + (size_t)tok * D + 1024 + c0;
                *(u32x4*)yr = w[0]; *(u32x4*)(yr + 8) = w[1];
            }
#pragma unroll
            for (int u = 0; u < 2; ++u)
#pragma unroll
                for (int i = 0; i < 2; ++i) { pc[u][i] = npc[u][i]; pp[u][i] = npp[u][i]; pn[u][i] = npn[u][i]; bg[u][i] = nbg[u][i]; }
        }
#undef CONV_LOAD
    }
}

#define LNH_STATS(v, mean, rstd) do { float s_ = 0.f; \
        _Pragma("unroll") for (int j = 0; j < 4; ++j) _Pragma("unroll") for (int e = 0; e < 8; e += 2) s_ += v[j][e] + v[j][e + 1]; \
        mean = wave_sum(s_) * (1.f / D); float s2_ = 0.f; \
        _Pragma("unroll") for (int j = 0; j < 4; ++j) _Pragma("unroll") for (int e = 0; e < 8; ++e) { v[j][e] -= mean; s2_ += v[j][e] * v[j][e]; } \
        rstd = 1.f / sqrtf(wave_sum(s2_) * (1.f / D) + LN_EPS); } while (0)
__device__ __forceinline__ void phase_ln_mid(const Params& p) {
    const int lane = threadIdx.x & 63, gw = blockIdx.x * 8 + (threadIdx.x >> 6), NGW = gridDim.x * 8;
    const float* modv = (const float*)(p.ws + WS_MOD); bf16_t* H = (bf16_t*)(p.ws + WS_H); const unsigned short* U1 = (const unsigned short*)(p.ws + WS_U1); float* stats = (float*)(p.ws + WS_STATS);
    f32x4 G1[4][2], B1[4][2];
#pragma unroll
    for (int j = 0; j < 4; ++j)
#pragma unroll
        for (int h = 0; h < 2; ++h) { const int c = 8 * (lane + 64 * j) + 4 * h; G1[j][h] = *(const f32x4*)(p.ln1_g + c); B1[j][h] = *(const f32x4*)(p.ln1_b + c); }
    for (int row0 = gw; row0 < T; row0 += 2 * NGW) {
        const int row1 = (row0 + NGW < T) ? row0 + NGW : row0;
        u32x4 ra[4], rb[4];
#pragma unroll
        for (int j = 0; j < 4; ++j) { ra[j] = ((const u32x4*)(U1 + (size_t)row0 * D) + lane)[64 * j]; rb[j] = ((const u32x4*)(U1 + (size_t)row1 * D) + lane)[64 * j]; }
#pragma unroll
        for (int r = 0; r < 2; ++r) {
            if (r == 1 && row1 == row0) break;
            const int row = r == 0 ? row0 : row1;
            const float* mv = modv + (row < SEQ ? 0 : 12288);
            float v[4][8];
#pragma unroll
            for (int j = 0; j < 4; ++j) unpack_h8(r == 0 ? ra[j] : rb[j], v[j]);
            float mean, rstd; LNH_STATS(v, mean, rstd);
            if (lane == 0) *(f32x2*)(stats + 2 * row) = (f32x2){mean, rstd};
#pragma unroll
            for (int j = 0; j < 4; ++j) { const int c = 8 * (lane + 64 * j);
#pragma unroll
                for (int h = 0; h < 2; ++h) { const f32x4 g = G1[j][h], bb = B1[j][h];
#pragma unroll
                    for (int e = 0; e < 4; ++e) v[j][4 * h + e] = (v[j][4 * h + e] * rstd) * g[e] + bb[e]; } }
            float mean2, rstd2; LNH_STATS(v, mean2, rstd2);
            u32x4* o16 = (u32x4*)(H + (size_t)row * D) + lane;
#pragma unroll
            for (int j = 0; j < 4; ++j) { const int c = 8 * (lane + 64 * j); float hh[8];
#pragma unroll
                for (int h = 0; h < 2; ++h) { const f32x4 sh = *(const f32x4*)(mv + 3 * 2048 + c + 4 * h), sc = *(const f32x4*)(mv + 4 * 2048 + c + 4 * h);
#pragma unroll
                    for (int e = 0; e < 4; ++e) hh[4 * h + e] = (v[j][4 * h + e] * rstd2) * (1.f + sc[e]) + sh[e]; }
                u32x4 w; w.x = cvt_pk_bf16(hh[0], hh[1]); w.y = cvt_pk_bf16(hh[2], hh[3]); w.z = cvt_pk_bf16(hh[4], hh[5]); w.w = cvt_pk_bf16(hh[6], hh[7]); o16[64 * j] = w; }
        }
    }
}
__device__ __forceinline__ void phase_ln_out(const Params& p) {
    const int lane = threadIdx.x & 63, gw = blockIdx.x * 8 + (threadIdx.x >> 6), NGW = gridDim.x * 8;
    const unsigned short* U2 = (const unsigned short*)(p.ws + WS_H);
    f32x4 G2[4][2], B2[4][2];
#pragma unroll
    for (int j = 0; j < 4; ++j)
#pragma unroll
        for (int h = 0; h < 2; ++h) { const int c = 8 * (lane + 64 * j) + 4 * h; G2[j][h] = *(const f32x4*)(p.ln2_g + c); B2[j][h] = *(const f32x4*)(p.ln2_b + c); }
    for (int row0 = gw; row0 < T; row0 += 2 * NGW) {
        const int row1 = (row0 + NGW < T) ? row0 + NGW : row0;
        u32x4 ra[4], rb[4];
#pragma unroll
        for (int j = 0; j < 4; ++j) { ra[j] = ((const u32x4*)(U2 + (size_t)row0 * D) + lane)[64 * j]; rb[j] = ((const u32x4*)(U2 + (size_t)row1 * D) + lane)[64 * j]; }
#pragma unroll
        for (int r = 0; r < 2; ++r) {
            if (r == 1 && row1 == row0) break;
            float v[4][8];
#pragma unroll
            for (int j = 0; j < 4; ++j) unpack_h8(r == 0 ? ra[j] : rb[j], v[j]);
            float mean, rstd; LNH_STATS(v, mean, rstd);
            float* orow = p.out + (size_t)(r == 0 ? row0 : row1) * D;
#pragma unroll
            for (int j = 0; j < 4; ++j) { const int c = 8 * (lane + 64 * j);
#pragma unroll
                for (int h = 0; h < 2; ++h) { const f32x4 g = G2[j][h], bb = B2[j][h]; f32x4 o;
#pragma unroll
                    for (int e = 0; e < 4; ++e) o[e] = (v[j][4 * h + e] * rstd) * g[e] + bb[e];
                    *(f32x4*)(orow + c + 4 * h) = o; } }
        }
    }
}

__global__ void __launch_bounds__(512, 2) hymba_fwd(Params p) {
    extern __shared__ __attribute__((aligned(16))) unsigned char shm[];
    cg::grid_group grid = cg::this_grid();
    PG8_LAS unsigned char* lds3 = (PG8_LAS unsigned char*)shm;
    const int lo = p.lo, hi = p.hi;
#define IN(k) (lo <= (k) && (k) < hi)
    if (threadIdx.x == 0) { *(volatile PG8_LAS unsigned*)(lds3 + pg8::STAGE_BYTES) = 0u; *(volatile PG8_LAS unsigned*)(lds3 + pg8::STAGE_BYTES + 4) = 0u; }
    __syncthreads();
    XcdBarrier xbar = xcd_barrier_post((unsigned*)(p.ws + WS_BAR), (volatile PG8_LAS unsigned*)(lds3 + pg8::STAGE_BYTES));
    if (lo < 0) grid.sync();
#define SEAM(k) do { if ((k) + 1 < hi) xcd_barrier(xbar); } while (0)
    if (IN(0)) { phase_prep(p, shm); SEAM(0); }
    if (IN(1)) {
        const int NCW = (gridDim.x >= 64) ? 24 : 0;
        if ((int)blockIdx.x < NCW) {
            const int cb = (int)blockIdx.x / 12, cpn = (int)blockIdx.x % 12;
            ln_ctx_rows(p, T + cb * CTXL, CTXL);
            asm volatile("s_waitcnt vmcnt(0)" ::: "memory"); __syncthreads();
            pg8::Gemm g{(const bf16_t*)(p.ws + WS_H), (const bf16_t*)(p.ws + WS_WIN), TALL, NIN, D}; OneUnit S1{T / 256 + cb, cpn};
            EpiIn E{(unsigned short*)(p.ws + WS_G), (bf16_t*)(p.ws + WS_V), (bf16_t*)(p.ws + WS_Q), (bf16_t*)(p.ws + WS_GATE), (bf16_t*)(p.ws + WS_BG), (bf16_t*)(p.ws + WS_P), (const float*)(p.ws + WS_LB)};
            pg8::gemm_phase<EpiIn, OneUnit>(lds3, g, S1, E);
        } else {
            if (NCW == 0) phase_ln_in(p, T, TALL, (int)(blockIdx.x * 8 + (threadIdx.x >> 6)), (int)gridDim.x * 8);
            phase_ln_in(p, 0, T, (int)((blockIdx.x - NCW) * 8 + (threadIdx.x >> 6)), (int)(gridDim.x - NCW) * 8);
        }
        SEAM(1);
    }
    if (IN(2)) {
        const int Min = (gridDim.x >= 64) ? T : TALL;
        pg8::Gemm g{(const bf16_t*)(p.ws + WS_H), (const bf16_t*)(p.ws + WS_WIN), Min, NIN, D}; pg8::StaticOrder S; S.init(Min, NIN, (int)gridDim.x, (int)blockIdx.x);
        EpiIn E{(unsigned short*)(p.ws + WS_G), (bf16_t*)(p.ws + WS_V), (bf16_t*)(p.ws + WS_Q), (bf16_t*)(p.ws + WS_GATE), (bf16_t*)(p.ws + WS_BG), (bf16_t*)(p.ws + WS_P), (const float*)(p.ws + WS_LB)};
        pg8::gemm_phase<EpiIn, pg8::StaticOrder>(lds3, g, S, E); SEAM(2);
    }
    if (IN(3)) { phase_scan1(p, shm); SEAM(3); }
    if (IN(4)) { phase_scan2(p, shm); SEAM(4); }
    if (IN(5)) { phase_combine(p); SEAM(5); }
    if (IN(6)) {
        pg8::Gemm g{(const bf16_t*)(p.ws + WS_Y), (const bf16_t*)(p.ws + WS_WOUT), T, D, D}; pg8::StaticOrder S; S.init(T, D, (int)gridDim.x, (int)blockIdx.x);
        EpiOut E{p.x, (const float*)(p.ws + WS_MOD), (unsigned short*)(p.ws + WS_U1)};
        pg8::gemm_phase<EpiOut, pg8::StaticOrder>(lds3, g, S, E); SEAM(6);
    }
    if (IN(7)) { phase_ln_mid(p); SEAM(7); }
    if (IN(8)) {
        pg8::Gemm g{(const bf16_t*)(p.ws + WS_H), (const bf16_t*)(p.ws + WS_WGU), T, NGU, D}; pg8::StaticOrder S; S.init(T, NGU, (int)gridDim.x, (int)blockIdx.x);
        EpiGU E{(bf16_t*)(p.ws + WS_HID)};
        pg8::gemm_phase<EpiGU, pg8::StaticOrder>(lds3, g, S, E); SEAM(8);
    }
    if (IN(9)) {
        pg8::Gemm g{(const bf16_t*)(p.ws + WS_HID), (const bf16_t*)(p.ws + WS_WDN), T, D, DFF}; pg8::StaticOrder S; S.init(T, D, (int)gridDim.x, (int)blockIdx.x);
        EpiDown E{(const unsigned short*)(p.ws + WS_U1), (const float*)(p.ws + WS_STATS), (const float*)(p.ws + WS_MOD), p.ln1_g, p.ln1_b, (unsigned short*)(p.ws + WS_H)};
        pg8::gemm_phase<EpiDown, pg8::StaticOrder>(lds3, g, S, E); SEAM(9);
    }
    if (IN(10)) { phase_ln_out(p); }
#undef IN
#undef SEAM
}

extern "C" void kernel_launch(void* const* d_in, const int* in_sizes, int n_in, void* d_out, int out_size, void* d_ws, size_t ws_size, hipStream_t stream) {
    constexpr int LDS_BYTES = pg8::STAGE_BYTES + 16;
    static int grid = 0;
    if (grid == 0) {
        if (n_in != 18 || ws_size < WS_END) { fprintf(stderr, "kernel_launch: unexpected inputs (n_in %d, ws %zu < %zu)\n", n_in, ws_size, (size_t)WS_END); grid = -1; return; }
        int dev = 0, cus = 0, per_cu = 0;
        (void)hipGetDevice(&dev); (void)hipDeviceGetAttribute(&cus, hipDeviceAttributeMultiprocessorCount, dev);
        if (hipFuncSetAttribute((const void*)hymba_fwd, hipFuncAttributeMaxDynamicSharedMemorySize, LDS_BYTES) != hipSuccess) { fprintf(stderr, "kernel_launch: hipFuncSetAttribute failed\n"); grid = -1; return; }
        if (hipOccupancyMaxActiveBlocksPerMultiprocessor(&per_cu, (const void*)hymba_fwd, 512, LDS_BYTES) != hipSuccess || per_cu < 1) { fprintf(stderr, "kernel_launch: occupancy query says %d\n", per_cu); per_cu = 1; }
        (void)hipGetLastError();
        grid = cus * 1;
    }
    if (grid < 0) return;
    if (hipMemsetAsync((char*)d_ws + WS_BAR, 0, 16384, stream) != hipSuccess) { fprintf(stderr, "kernel_launch: memset of the barrier words failed\n"); return; }
    Params p{};
    const float** pp = (const float**)&p;
    for (int i = 0; i < 18; ++i) pp[i] = (const float*)d_in[i];
    p.out = (float*)d_out; p.ws = (unsigned char*)d_ws;
#if ONE_LAUNCH
    p.lo = 0; p.hi = 11;
    void* args[] = {&p};
    hipError_t e = hipLaunchCooperativeKernel((const void*)hymba_fwd, dim3(grid), dim3(512), args, LDS_BYTES, stream);
    if (e != hipSuccess) fprintf(stderr, "cooperative launch failed: %s (grid %d)\n", hipGetErrorString(e), grid);
#else
    for (int k = 0; k < 11; ++k) { p.lo = k; p.hi = k + 1; hipLaunchKernelGGL(hymba_fwd, dim3(grid), dim3(512), LDS_BYTES, stream, p); }
#endif
}
```

```cpp
#include <hip/hip_runtime.h>
#include <hip/hip_cooperative_groups.h>
#include <cstdio>
namespace cg = cooperative_groups;

#ifndef ONE_LAUNCH
#define ONE_LAUNCH 1
#endif

#define PG8_LAS __attribute__((address_space(3)))
typedef unsigned short bf16_t;
typedef short bf16x8 __attribute__((ext_vector_type(8)));
typedef float f32x4 __attribute__((ext_vector_type(4)));
typedef float f32x2 __attribute__((ext_vector_type(2)));
typedef unsigned u32x4 __attribute__((ext_vector_type(4)));
typedef unsigned u32x2 __attribute__((ext_vector_type(2)));
typedef _Float16 h16x2 __attribute__((ext_vector_type(2)));

constexpr int D = 2048, T = 32768, TALL = 33280, SEQ = 16384, CTXL = 256, HW = 1024, NIN = 8192, DFF = 5632, NGU = 11264;
constexpr float ALPHA = 1.189207115002721f, LN_EPS = 1e-6f, RMS_EPS = 1e-6f;

constexpr size_t WS_WIN = 0;
constexpr size_t WS_WOUT = WS_WIN + (size_t)NIN * D * 2;
constexpr size_t WS_WGU = WS_WOUT + (size_t)D * D * 2;
constexpr size_t WS_WDN = WS_WGU + (size_t)NGU * D * 2;
constexpr size_t WS_MOD = WS_WDN + (size_t)D * DFF * 2;
constexpr size_t WS_LB = WS_MOD + 3 * 12288 * 4;
constexpr size_t WS_STATS = WS_LB + 2048 * 4;
constexpr size_t WS_SEG = WS_STATS + (size_t)T * 8;
constexpr size_t WS_SEGDEC = WS_SEG + (size_t)32 * 8 * 65536;
constexpr size_t WS_H = WS_SEGDEC + 32 * 8 * 128 * 4;
constexpr size_t WS_V = WS_H + (size_t)TALL * D * 2;
constexpr size_t WS_Q = WS_V + (size_t)TALL * HW * 2;
constexpr size_t WS_GATE = WS_Q + (size_t)T * HW * 2;
constexpr size_t WS_BG = WS_GATE + (size_t)T * HW * 2;
constexpr size_t WS_U1 = WS_V;
constexpr size_t WS_P = WS_BG + (size_t)T * HW * 2;
constexpr size_t WS_G = WS_P + (size_t)T * HW * 2;
constexpr size_t WS_Y = WS_G;
constexpr size_t WS_O = WS_G + (size_t)TALL * D * 2;
constexpr size_t WS_HID = WS_P;
constexpr size_t WS_BAR = WS_HID + (size_t)T * DFF * 2;
constexpr size_t WS_END = WS_BAR + 16384;
static_assert(WS_O + (size_t)2 * T * HW * 2 <= WS_END, "ws map");
static_assert(WS_U1 + (size_t)T * D * 4 <= WS_P, "ws map u1");

typedef __bf16 bf16v2_t __attribute__((ext_vector_type(2)));
__device__ __forceinline__ unsigned cvt_pk_bf16(float lo, float hi) { const bf16v2_t v = __builtin_convertvector((f32x2){lo, hi}, bf16v2_t); return __builtin_bit_cast(unsigned, v); }
__device__ __forceinline__ float bf2f(unsigned short b) { return __uint_as_float(((unsigned)b) << 16); }
__device__ __forceinline__ float h2f(unsigned short b) { return (float)__builtin_bit_cast(_Float16, b); }
__device__ __forceinline__ unsigned pk_h2(float a, float b) { h16x2 v; v.x = (_Float16)a; v.y = (_Float16)b; return __builtin_bit_cast(unsigned, v); }
__device__ __forceinline__ void unpack_h8(const u32x4 w, float (&f)[8]) {
#pragma unroll
    for (int i = 0; i < 4; ++i) { const h16x2 h = __builtin_bit_cast(h16x2, (unsigned)w[i]); f[2 * i] = (float)h.x; f[2 * i + 1] = (float)h.y; }
}
__device__ __forceinline__ float silu_f(float v) { return v * __builtin_amdgcn_rcpf(1.0f + __expf(-v)); }
__device__ __forceinline__ float wave_sum(float v) {
#pragma unroll
    for (int o = 1; o < 64; o <<= 1) v += __shfl_xor(v, o);
    return v;
}

namespace pg8 {
constexpr int BM = 256, BK = 64, HALF = 128, HTB = HALF * BK * 2, STAGE_BYTES = 8 * HTB, NXCD = 8, WGM = 8;
__host__ __device__ __forceinline__ int lds_byte(int r, int c) { const int st = (r >> 4) * 2 + (c >> 5), rr = r & 15, cc = c & 31, ob = rr * 64 + cc * 2; return st * 1024 + (ob ^ (((ob >> 9) & 1) << 5)); }
__host__ __device__ __forceinline__ void stage_rc(int b, int& R, int& C) { const int st = b / 1024, sb = b % 1024, swz = sb ^ (((sb >> 9) & 1) << 5); R = (st >> 1) * 16 + swz / 64; C = (st & 1) * 32 + (swz % 64) / 2; }
__host__ __device__ __forceinline__ int perm32(int rho) { const int n = rho >> 4, i = rho & 15; return 8 * (i >> 2) + 4 * n + (i & 3); }
struct Unit { int pm, pn; };
struct Gemm { const bf16_t* A; const bf16_t* Bt; int M, N, K; };
struct StaticOrder {
    int nM, nN, nwg, G, c;
    __host__ __device__ void init(int M, int N, int G_, int c_) { nM = M / BM; nN = N / BM; nwg = nM * nN; G = G_; c = c_; }
    __host__ __device__ bool next(int i, Unit& u) const {
        const long L = (long)i * G + c; if (L >= nwg) return false;
        int wgid = (int)L; { const int q = nwg / NXCD, r = nwg % NXCD, xcd = wgid % NXCD, off = wgid / NXCD; wgid = (xcd < r ? xcd * (q + 1) : r * (q + 1) + (xcd - r) * q) + off; }
        const int nig = WGM * nN, gid = wgid / nig, fm = gid * WGM, gsz = (nM - fm) < WGM ? (nM - fm) : WGM;
        u.pm = fm + ((wgid % nig) % gsz); u.pn = (wgid % nig) / gsz; return true;
    }
    __device__ __forceinline__ void a_ready(const Unit&) const {}
    __device__ __forceinline__ void done(const Unit&) const {}
};

template <class Epi, class Sched>
__device__ __forceinline__ void gemm_phase(PG8_LAS unsigned char* lds, const Gemm g, const Sched& S, const Epi& E) {
    const int tid = threadIdx.x, wid = __builtin_amdgcn_readfirstlane(tid >> 6), lane = tid & 63, wr = wid >> 2, wc = wid & 3, fr = lane & 15, fq = lane >> 4;
    const int K = g.K, nt = K / BK;
    unsigned voffA[2], voffB[2];
#pragma unroll
    for (int i = 0; i < 2; ++i) { int R, C; stage_rc(tid * 16 + i * 8192, R, C); const int Rb = Epi::PERM ? ((R & ~31) + perm32(R & 31)) : R;
        voffA[i] = (unsigned)(R * K + C) * 2u; voffB[i] = (unsigned)(Rb * K + C) * 2u; }
    const size_t kstep = (size_t)(BK * 2);
    const size_t hstep = (size_t)HALF * K * 2;
    const size_t tstep = 2 * hstep;
    const unsigned ldsw = (unsigned)wid * 1024u;
    const int aoff = lds_byte(wr * 64 + fr, fq * 8), boff = lds_byte(wc * 32 + fr, fq * 8);
#define PG8_SA(b, h) (((b) * 2 + (h)) * HTB)
#define PG8_SB(b, h) ((4 + (b) * 2 + (h)) * HTB)
#define PG8_STAGE(bufoff, gbase, voff) do { _Pragma("unroll") for (int _i = 0; _i < 2; ++_i) \
        __builtin_amdgcn_global_load_lds((const unsigned*)((const char*)(gbase) + (voff)[_i]), (PG8_LAS unsigned*)(lds + (bufoff) + ldsw + _i * 8192), 16, 0, 0); } while (0)
#define PG8_LDA(dst, b, h) do { _Pragma("unroll") for (int m = 0; m < 4; ++m) _Pragma("unroll") for (int k = 0; k < 2; ++k) dst[m][k] = *(const PG8_LAS bf16x8*)(lds + PG8_SA(b, h) + aoff + m * 2048 + k * 1024); } while (0)
#define PG8_LDB(dst, b, h) do { _Pragma("unroll") for (int n = 0; n < 2; ++n) _Pragma("unroll") for (int k = 0; k < 2; ++k) dst[n][k] = *(const PG8_LAS bf16x8*)(lds + PG8_SB(b, h) + boff + n * 2048 + k * 1024); } while (0)
#define PG8_MMA(ai, bj, At, Bt) do { __builtin_amdgcn_s_setprio(1); _Pragma("unroll") for (int m = 0; m < 4; ++m) _Pragma("unroll") for (int n = 0; n < 2; ++n) _Pragma("unroll") for (int k = 0; k < 2; ++k) \
        acc[ai][bj][m][n] = __builtin_amdgcn_mfma_f32_16x16x32_bf16(Bt[n][k], At[m][k], acc[ai][bj][m][n], 0, 0, 0); __builtin_amdgcn_s_setprio(0); } while (0)
#define PG8_WAIT_V(n) asm volatile("s_waitcnt vmcnt(" #n ")" ::: "memory")
#define PG8_WAIT_L(n) asm volatile("s_waitcnt lgkmcnt(" #n ")" ::: "memory")
#define PG8_BAR __builtin_amdgcn_s_barrier()
#define PG8_SCHED __builtin_amdgcn_sched_barrier(0)
    Unit cur, nxt; int ui = 0;
    if (!S.next(0, cur)) return;
    f32x4 acc[2][2][4][2];
#pragma unroll
    for (int a = 0; a < 2; ++a)
#pragma unroll
        for (int b = 0; b < 2; ++b)
#pragma unroll
            for (int m = 0; m < 4; ++m)
#pragma unroll
                for (int n = 0; n < 2; ++n) acc[a][b][m][n] = (f32x4){0.f, 0.f, 0.f, 0.f};
    bf16x8 At[4][2], B0[2][2], B1[2][2];
    const char* cA = (const char*)g.A + (size_t)cur.pm * tstep; const char* cB = (const char*)g.Bt + (size_t)cur.pn * tstep;
    S.a_ready(cur);
    PG8_STAGE(PG8_SB(0, 0), cB, voffB); PG8_STAGE(PG8_SA(0, 0), cA, voffA); PG8_STAGE(PG8_SB(0, 1), cB + hstep, voffB); PG8_STAGE(PG8_SA(0, 1), cA + hstep, voffA);
    if (wr == 1) PG8_BAR;
    PG8_WAIT_V(4); PG8_BAR;
    PG8_STAGE(PG8_SB(1, 0), cB + kstep, voffB); PG8_STAGE(PG8_SA(1, 0), cA + kstep, voffA); PG8_STAGE(PG8_SB(1, 1), cB + hstep + kstep, voffB);
    PG8_WAIT_V(6); PG8_BAR;
    for (;;) {
        const bool has_next = S.next(ui + 1, nxt);
        const char* nA = has_next ? (const char*)g.A + (size_t)nxt.pm * tstep : cA; const char* nB = has_next ? (const char*)g.Bt + (size_t)nxt.pn * tstep : cB;
        for (int t = 0; t < nt; t += 2) {
            const bool last = (t == nt - 2);
            const char* a1 = cA + (size_t)(t + 1) * kstep;
            const char* a2 = last ? nA : cA + (size_t)(t + 2) * kstep; const char* b2 = last ? nB : cB + (size_t)(t + 2) * kstep;
            const char* a3 = a2 + kstep; const char* b3 = b2 + kstep;
            if (last && has_next) S.a_ready(nxt);
            PG8_LDB(B0, 0, 0); PG8_SCHED; PG8_LDA(At, 0, 0); PG8_STAGE(PG8_SA(1, 1), a1 + hstep, voffA);
            PG8_WAIT_L(8); PG8_BAR; PG8_WAIT_L(0); PG8_MMA(0, 0, At, B0); PG8_BAR; PG8_SCHED;
            PG8_LDB(B1, 0, 1); PG8_STAGE(PG8_SB(0, 0), b2, voffB);
            PG8_BAR; PG8_WAIT_L(0); PG8_MMA(0, 1, At, B1); PG8_BAR;
            PG8_LDA(At, 0, 1); PG8_STAGE(PG8_SA(0, 0), a2, voffA);
            PG8_BAR; PG8_WAIT_L(0); PG8_MMA(1, 0, At, B0); PG8_BAR; PG8_SCHED;
            PG8_STAGE(PG8_SB(0, 1), b2 + hstep, voffB);
            PG8_WAIT_V(6); PG8_BAR; PG8_MMA(1, 1, At, B1); PG8_BAR;
            PG8_LDB(B0, 1, 0); PG8_SCHED; PG8_LDA(At, 1, 0); PG8_STAGE(PG8_SA(0, 1), a2 + hstep, voffA);
            PG8_WAIT_L(8); PG8_BAR; PG8_WAIT_L(0); PG8_MMA(0, 0, At, B0); PG8_BAR; PG8_SCHED;
            PG8_LDB(B1, 1, 1); PG8_STAGE(PG8_SB(1, 0), b3, voffB);
            PG8_BAR; PG8_WAIT_L(0); PG8_MMA(0, 1, At, B1); PG8_BAR;
            PG8_LDA(At, 1, 1); PG8_STAGE(PG8_SA(1, 0), a3, voffA);
            PG8_BAR; PG8_WAIT_L(0); PG8_MMA(1, 0, At, B0); PG8_BAR; PG8_SCHED;
            PG8_STAGE(PG8_SB(1, 1), b3 + hstep, voffB);
            PG8_WAIT_V(6); PG8_BAR; PG8_MMA(1, 1, At, B1); PG8_BAR;
        }
        E(acc, cur, wr, wc, fr, fq); S.done(cur);
        if (!has_next) break;
#pragma unroll
        for (int a = 0; a < 2; ++a)
#pragma unroll
            for (int b = 0; b < 2; ++b)
#pragma unroll
                for (int m = 0; m < 4; ++m)
#pragma unroll
                    for (int n = 0; n < 2; ++n) acc[a][b][m][n] = (f32x4){0.f, 0.f, 0.f, 0.f};
        cur = nxt; cA = nA; cB = nB; ++ui;
    }
    PG8_WAIT_V(0);
    if (wr == 0) PG8_BAR;
    PG8_BAR;
#undef PG8_SA
#undef PG8_SB
#undef PG8_STAGE
#undef PG8_LDA
#undef PG8_LDB
#undef PG8_MMA
#undef PG8_WAIT_V
#undef PG8_WAIT_L
#undef PG8_BAR
#undef PG8_SCHED
}
}

typedef f32x4 AccT[2][2][4][2];

struct EpiIn {
    static constexpr bool PERM = true;
    unsigned short* G; bf16_t* V; bf16_t* Q; bf16_t* GATE; bf16_t* BG; bf16_t* P; const float* lb;
    __device__ __forceinline__ void operator()(const AccT& acc, const pg8::Unit& u, int wr, int wc, int fr, int fq) const {
        const int row0 = u.pm * 256 + wr * 64 + fr, cl = wc * 32 + 8 * fq, pn = u.pn;
        if (pn < 8) {
#pragma unroll
            for (int bj = 0; bj < 2; ++bj) {
                const int col = pn * 256 + bj * 128 + cl;
                const f32x4 l0 = *(const f32x4*)(lb + col), l1 = *(const f32x4*)(lb + col + 4);
#pragma unroll
                for (int ai = 0; ai < 2; ++ai)
#pragma unroll
                    for (int m = 0; m < 4; ++m) {
                        const f32x4 a = acc[ai][bj][m][0], b = acc[ai][bj][m][1]; float g[8];
#pragma unroll
                        for (int j = 0; j < 4; ++j) { g[j] = (1.f - l0[j]) * __builtin_amdgcn_rcpf(1.f + __expf(a[j])); g[4 + j] = (1.f - l1[j]) * __builtin_amdgcn_rcpf(1.f + __expf(b[j])); }
                        u32x4 w; w.x = pk_h2(g[0], g[1]); w.y = pk_h2(g[2], g[3]); w.z = pk_h2(g[4], g[5]); w.w = pk_h2(g[6], g[7]);
                        *(u32x4*)(G + (size_t)(row0 + ai * 128 + m * 16) * 2048 + col) = w;
                    }
            }
        } else if (pn < 24) {
            if (u.pm >= 128 && pn >= 12) return;
            const int ty = (pn - 8) >> 2; bf16_t* base = V + (ty == 0 ? (size_t)0 : (size_t)TALL * HW + (size_t)(ty - 1) * T * HW);
            const bool act = (ty == 1);
            const int colt = (pn - 8 - 4 * ty) * 256;
#pragma unroll
            for (int ai = 0; ai < 2; ++ai)
#pragma unroll
                for (int m = 0; m < 4; ++m)
#pragma unroll
                    for (int bj = 0; bj < 2; ++bj) {
                        f32x4 a = acc[ai][bj][m][0], b = acc[ai][bj][m][1];
                        if (act) {
#pragma unroll
                            for (int j = 0; j < 4; ++j) { a[j] = silu_f(a[j]); b[j] = silu_f(b[j]); } }
                        u32x4 w; w.x = cvt_pk_bf16(a[0], a[1]); w.y = cvt_pk_bf16(a[2], a[3]); w.z = cvt_pk_bf16(b[0], b[1]); w.w = cvt_pk_bf16(b[2], b[3]);
                        *(u32x4*)(base + (size_t)(row0 + ai * 128 + m * 16) * 1024 + colt + bj * 128 + cl) = w;
                    }
        } else {
            if (u.pm >= 128) return;
            const int col = (pn - 24) * 128 + cl;
#pragma unroll
            for (int ai = 0; ai < 2; ++ai)
#pragma unroll
                for (int m = 0; m < 4; ++m) {
                    const f32x4 a = acc[ai][0][m][0] * acc[ai][1][m][0], b = acc[ai][0][m][1] * acc[ai][1][m][1];
                    u32x4 w; w.x = cvt_pk_bf16(a[0], a[1]); w.y = cvt_pk_bf16(a[2], a[3]); w.z = cvt_pk_bf16(b[0], b[1]); w.w = cvt_pk_bf16(b[2], b[3]);
                    *(u32x4*)(P + (size_t)(row0 + ai * 128 + m * 16) * 1024 + col) = w;
                }
        }
    }
};
struct EpiOut {
    static constexpr bool PERM = true;
    const float* x; const float* mod; unsigned short* U1;
    __device__ __forceinline__ void operator()(const AccT& acc, const pg8::Unit& u, int wr, int wc, int fr, int fq) const {
        const int row0 = u.pm * 256 + wr * 64 + fr, col0 = u.pn * 256 + wc * 32 + 8 * fq;
        const float* ga = mod + (u.pm >= 64 ? 12288 : 0) + 2 * 2048;
        f32x4 gv[2][2];
#pragma unroll
        for (int bj = 0; bj < 2; ++bj)
#pragma unroll
            for (int n = 0; n < 2; ++n) gv[bj][n] = *(const f32x4*)(ga + col0 + bj * 128 + n * 4);
#pragma unroll
        for (int ai = 0; ai < 2; ++ai) {
            f32x4 xa[4][2], xb[4][2];
#pragma unroll
            for (int m = 0; m < 4; ++m) { const size_t off = (size_t)(row0 + ai * 128 + m * 16) * D + col0;
#pragma unroll
                for (int bj = 0; bj < 2; ++bj) { xa[m][bj] = *(const f32x4*)(x + off + bj * 128); xb[m][bj] = *(const f32x4*)(x + off + bj * 128 + 4); } }
#pragma unroll
            for (int m = 0; m < 4; ++m) { const size_t off = (size_t)(row0 + ai * 128 + m * 16) * D + col0;
#pragma unroll
                for (int bj = 0; bj < 2; ++bj) {
                    const f32x4 a = ALPHA * xa[m][bj] + gv[bj][0] * acc[ai][bj][m][0], b = ALPHA * xb[m][bj] + gv[bj][1] * acc[ai][bj][m][1];
                    u32x4 w; w.x = pk_h2(a[0], a[1]); w.y = pk_h2(a[2], a[3]); w.z = pk_h2(b[0], b[1]); w.w = pk_h2(b[2], b[3]);
                    *(u32x4*)(U1 + off + bj * 128) = w; } }
        }
    }
};
struct EpiGU {
    static constexpr bool PERM = true;
    bf16_t* HID;
    __device__ __forceinline__ void operator()(const AccT& acc, const pg8::Unit& u, int wr, int wc, int fr, int fq) const {
        const int row0 = u.pm * 256 + wr * 64 + fr, col = u.pn * 128 + wc * 32 + 8 * fq;
#pragma unroll
        for (int ai = 0; ai < 2; ++ai)
#pragma unroll
            for (int m = 0; m < 4; ++m) {
                f32x4 a = acc[ai][0][m][0], b = acc[ai][0][m][1];
#pragma unroll
                for (int j = 0; j < 4; ++j) { a[j] = silu_f(a[j]) * acc[ai][1][m][0][j]; b[j] = silu_f(b[j]) * acc[ai][1][m][1][j]; }
                u32x4 w; w.x = cvt_pk_bf16(a[0], a[1]); w.y = cvt_pk_bf16(a[2], a[3]); w.z = cvt_pk_bf16(b[0], b[1]); w.w = cvt_pk_bf16(b[2], b[3]);
                *(u32x4*)(HID + (size_t)(row0 + ai * 128 + m * 16) * DFF + col) = w;
            }
    }
};
struct EpiDown {
    static constexpr bool PERM = true;
    const unsigned short* U1; const float* stats; const float* mod; const float* g1; const float* b1; unsigned short* U2;
    __device__ __forceinline__ void operator()(const AccT& acc, const pg8::Unit& u, int wr, int wc, int fr, int fq) const {
        const int row0 = u.pm * 256 + wr * 64 + fr, col0 = u.pn * 256 + wc * 32 + 8 * fq;
        const float* ga = mod + (u.pm >= 64 ? 12288 : 0) + 5 * 2048;
        f32x4 gv[2][2], lg[2][2], lbv[2][2];
#pragma unroll
        for (int bj = 0; bj < 2; ++bj)
#pragma unroll
            for (int n = 0; n < 2; ++n) { const int c = col0 + bj * 128 + n * 4; gv[bj][n] = *(const f32x4*)(ga + c); lg[bj][n] = ALPHA * *(const f32x4*)(g1 + c); lbv[bj][n] = ALPHA * *(const f32x4*)(b1 + c); }
#pragma unroll
        for (int ai = 0; ai < 2; ++ai) {
            u32x4 uraw[4][2]; f32x2 stv[4];
#pragma unroll
            for (int m = 0; m < 4; ++m) { const int row = row0 + ai * 128 + m * 16; const size_t off = (size_t)row * D + col0; stv[m] = *(const f32x2*)(stats + 2 * row);
#pragma unroll
                for (int bj = 0; bj < 2; ++bj) uraw[m][bj] = *(const u32x4*)(U1 + off + bj * 128); }
#pragma unroll
            for (int m = 0; m < 4; ++m) { const int row = row0 + ai * 128 + m * 16; const size_t off = (size_t)row * D + col0; const f32x2 st = stv[m];
#pragma unroll
                for (int bj = 0; bj < 2; ++bj) { float uf[8]; unpack_h8(uraw[m][bj], uf);
                    const f32x4 ua = {uf[0], uf[1], uf[2], uf[3]}, ub = {uf[4], uf[5], uf[6], uf[7]};
                    const f32x4 a = ((ua - st.x) * st.y) * lg[bj][0] + lbv[bj][0] + gv[bj][0] * acc[ai][bj][m][0], b = ((ub - st.x) * st.y) * lg[bj][1] + lbv[bj][1] + gv[bj][1] * acc[ai][bj][m][1];
                    u32x4 w; w.x = pk_h2(a[0], a[1]); w.y = pk_h2(a[2], a[3]); w.z = pk_h2(b[0], b[1]); w.w = pk_h2(b[2], b[3]);
                    *(u32x4*)(U2 + off + bj * 128) = w; } }
        }
    }
};
#define XB_TMO      128
#define XB_XCNT(j)  (256  + 64 * (j))
#define XB_XSUB(j)  (1280 + 64 * (j))
#define XB_XGEN(j)  (2304 + 64 * (j))
#define XB_TOP      3328
#define XB_TOPGEN   3392
#define XCD_BAR_WORDS 3456
#define XB_SPIN_CAP (1u << 18)
__device__ __forceinline__ unsigned xb_ld(unsigned* p)              { return __hip_atomic_load(p, __ATOMIC_RELAXED, __HIP_MEMORY_SCOPE_AGENT); }
__device__ __forceinline__ unsigned xb_add(unsigned* p, unsigned v) { return __hip_atomic_fetch_add(p, v, __ATOMIC_RELAXED, __HIP_MEMORY_SCOPE_AGENT); }
__device__ __forceinline__ unsigned xb_xcc_id() { return (unsigned)__builtin_amdgcn_s_getreg((3 << 11) | 20) & 0xFu; }
#define XB_SPIN(cond, bar) do { unsigned _sp = 0; while (cond) { __builtin_amdgcn_s_sleep(1); \
    if ((++_sp & 255u) == 0u) { if (xb_ld(&(bar)[XB_TMO])) break; if (_sp > XB_SPIN_CAP) { atomicAdd(&(bar)[XB_TMO], 1u); break; } } } } while (0)
struct XcdBarrier { unsigned* bar; unsigned x; volatile PG8_LAS unsigned* st; };
__device__ __forceinline__ XcdBarrier xcd_barrier_post(unsigned* bar, volatile PG8_LAS unsigned* st) {
    XcdBarrier b; b.bar = bar; b.x = xb_xcc_id(); b.st = st;
    if (threadIdx.x == 0) (void)xb_add(&bar[XB_XCNT(b.x)], 1u);
    return b;
}
__device__ __forceinline__ void xcd_barrier_complete(unsigned* bar, unsigned x, unsigned& nloc, unsigned& nx) {
    const unsigned G = gridDim.x * gridDim.y * gridDim.z;
    unsigned sum, cnt, mine, sp = 0u;
    for (;;) {
        sum = 0u; cnt = 0u; mine = 0u;
#pragma unroll
        for (unsigned j = 0; j < 16; ++j) { const unsigned c = xb_ld(&bar[XB_XCNT(j)]); sum += c; cnt += (c > 0u) ? 1u : 0u; mine = (j == x) ? c : mine; }
        if (sum == G) break;
        __builtin_amdgcn_s_sleep(1);
        if ((++sp & 255u) == 0u) { if (xb_ld(&bar[XB_TMO])) break; if (sp > XB_SPIN_CAP) { atomicAdd(&bar[XB_TMO], 1u); break; } }
    }
    nloc = mine > 0u ? mine : 1u; nx = cnt > 0u ? cnt : 1u;
}
__device__ __forceinline__ void xcd_barrier(const XcdBarrier& b) {
    asm volatile("s_waitcnt vmcnt(0)" ::: "memory");
    __syncthreads();
    if (threadIdx.x == 0) {
        unsigned* bar = b.bar;
        __builtin_amdgcn_s_waitcnt(0);
        unsigned nloc = b.st[0], nx = b.st[1];
        if (nloc == 0u) { xcd_barrier_complete(bar, b.x, nloc, nx); b.st[0] = nloc; b.st[1] = nx; }
        const unsigned old = xb_add(&bar[XB_XSUB(b.x)], 1u);
        const unsigned gen = old / nloc;
        if (old + 1u == (gen + 1u) * nloc) {
            __builtin_amdgcn_fence(__ATOMIC_RELEASE, "agent");
            asm volatile("s_waitcnt vmcnt(0)" ::: "memory");
            const unsigned og = xb_add(&bar[XB_TOP], 1u);
            const unsigned tg = og / nx;
            if (og + 1u == (tg + 1u) * nx) xb_add(&bar[XB_TOPGEN], 1u);
            else XB_SPIN(xb_ld(&bar[XB_TOPGEN]) == tg, bar);
            __builtin_amdgcn_fence(__ATOMIC_ACQUIRE, "agent");
            xb_add(&bar[XB_XGEN(b.x)], 1u);
            asm volatile("s_waitcnt vmcnt(0)" ::: "memory");
        } else {
            XB_SPIN(xb_ld(&bar[XB_XGEN(b.x)]) == gen, bar);
            __builtin_amdgcn_fence(__ATOMIC_ACQUIRE, "agent");
            asm volatile("s_waitcnt vmcnt(0)" ::: "memory");
        }
    }
    __syncthreads();
}

struct OneUnit {
    int pm, pn;
    __device__ __forceinline__ bool next(int i, pg8::Unit& u) const { if (i != 0) return false; u.pm = pm; u.pn = pn; return true; }
    __device__ __forceinline__ void a_ready(const pg8::Unit&) const {}
    __device__ __forceinline__ void done(const pg8::Unit&) const {}
};

struct Params {
    const float *x, *c, *ctx, *cctx, *w_mod, *b_mod, *w_in, *lb_logits, *g_norm_w, *conv_w, *w_out, *ln1_g, *ln1_b, *w_gate, *w_up, *w_down, *ln2_g, *ln2_b;
    float* out; unsigned char* ws; int lo, hi;
};

__device__ __forceinline__ void transpose_item(const float* W, int N, bf16_t* WT, int K, int k0, int n0, int dest_row0, float*  , int lane) {
    typedef unsigned u32x2s __attribute__((ext_vector_type(2)));
    float tv[32];
#pragma unroll
    for (int i = 0; i < 32; ++i) tv[i] = W[(size_t)(k0 + 2 * i + (lane >> 5)) * N + n0 + (lane & 31)];
    unsigned pk[16];
#pragma unroll
    for (int i = 0; i < 16; ++i) {
        const u32x2s r = __builtin_amdgcn_permlane32_swap(__float_as_uint(tv[i]), __float_as_uint(tv[i + 16]), false, false);
        pk[i] = cvt_pk_bf16(__uint_as_float(r.x), __uint_as_float(r.y));
    }
    bf16_t* dst = WT + (size_t)(dest_row0 + (lane & 31)) * K + k0 + (lane >> 5) * 32;
#pragma unroll
    for (int j = 0; j < 4; ++j) *(u32x4*)(dst + 8 * j) = (u32x4){pk[4 * j], pk[4 * j + 1], pk[4 * j + 2], pk[4 * j + 3]};
}

__device__ __forceinline__ void phase_prep(const Params& p, unsigned char* lds) {
    const int tid = threadIdx.x, lane = tid & 63, wave = tid >> 6;
    float* modv = (float*)(p.ws + WS_MOD);
    {
        float* sc = (float*)lds;
        float* red = (float*)(lds + 24576);
        for (int i = tid; i < 3 * 2048; i += 512) { const int o = i >> 11, k = i & 2047; const float v = o == 0 ? p.c[k] : o == 1 ? p.c[2048 + k] : p.cctx[k]; sc[i] = silu_f(v); }
        __syncthreads();
        for (int item = blockIdx.x; item < 256; item += gridDim.x) {
            const int col0 = item * 48, kq = tid / 12, c4 = tid % 12;
            f32x4 a0 = {0, 0, 0, 0}, a1 = {0, 0, 0, 0}, a2 = {0, 0, 0, 0};
            if (kq < 42) {
#pragma unroll 16
                for (int k = kq; k < 2048; k += 42) {
                    const f32x4 w = *(const f32x4*)(p.w_mod + (size_t)k * 12288 + col0 + 4 * c4);
                    a0 += sc[k] * w; a1 += sc[2048 + k] * w; a2 += sc[4096 + k] * w;
                }
                float* r = red + (kq * 12 + c4) * 12;
                *(f32x4*)(r) = a0; *(f32x4*)(r + 4) = a1; *(f32x4*)(r + 8) = a2;
            }
            __syncthreads();
            if (tid < 144) { const int o = tid / 48, cc = tid % 48; float s = 0.f;
                for (int q = 0; q < 42; ++q) s += red[(q * 12 + (cc >> 2)) * 12 + o * 4 + (cc & 3)];
                modv[o * 12288 + col0 + cc] = s + p.b_mod[col0 + cc]; }
            __syncthreads();
        }
    }
    if (blockIdx.x < 4) { const int idx = blockIdx.x * 512 + tid, dir = idx >> 10, ch = idx & 1023;
        const float a0 = p.lb_logits[dir * 2048 + ch], a1 = p.lb_logits[dir * 2048 + 1024 + ch];
        ((float*)(p.ws + WS_LB))[idx] = 1.f / (1.f + __expf(a1 - a0)); }
    {
        const int gw = blockIdx.x * 8 + wave, NGW = gridDim.x * 8;
        constexpr int I_IN = 32 * 256, I_OUT = 32 * 64, I_G = 32 * 176, I_D = 88 * 64;
        constexpr int NITEMS = I_IN + I_OUT + 2 * I_G + I_D;
        bf16_t* Win = (bf16_t*)(p.ws + WS_WIN); bf16_t* Wout = (bf16_t*)(p.ws + WS_WOUT); bf16_t* Wgu = (bf16_t*)(p.ws + WS_WGU); bf16_t* Wdn = (bf16_t*)(p.ws + WS_WDN);
        typedef unsigned u32x2s __attribute__((ext_vector_type(2)));
        for (int it0 = gw; it0 < NITEMS; it0 += 2 * NGW) {
            const float* src[2]; bf16_t* dstp[2]; int srcN[2]; bool valid[2];
#pragma unroll
            for (int u = 0; u < 2; ++u) {
                int r = it0 + u * NGW; valid[u] = r < NITEMS; if (!valid[u]) r = it0;
                const float* W; int N, K, k0, n0, drow; bf16_t* WT;
                if (r < I_IN) { const int kb = r / 256, nb = r % 256; n0 = nb * 32; drow = n0;
                    if (n0 >= 6144) { const int isx = n0 >= 7168, j = n0 - (isx ? 7168 : 6144); drow = 6144 + 256 * (j >> 7) + 128 * isx + (j & 127); }
                    W = p.w_in; N = NIN; WT = Win; K = D; k0 = kb * 64; }
                else if (r < I_IN + I_OUT) { r -= I_IN; const int kb = r / 64, nb = r % 64; W = p.w_out; N = D; WT = Wout; K = D; k0 = kb * 64; n0 = nb * 32; drow = n0; }
                else if (r < I_IN + I_OUT + I_G) { r -= I_IN + I_OUT; const int kb = r / 176, nb = r % 176; n0 = nb * 32; W = p.w_gate; N = DFF; WT = Wgu; K = D; k0 = kb * 64; drow = 256 * (n0 >> 7) + (n0 & 127); }
                else if (r < I_IN + I_OUT + 2 * I_G) { r -= I_IN + I_OUT + I_G; const int kb = r / 176, nb = r % 176; n0 = nb * 32; W = p.w_up; N = DFF; WT = Wgu; K = D; k0 = kb * 64; drow = 256 * (n0 >> 7) + 128 + (n0 & 127); }
                else { r -= I_IN + I_OUT + 2 * I_G; const int kb = r / 64, nb = r % 64; W = p.w_down; N = D; WT = Wdn; K = DFF; k0 = kb * 64; n0 = nb * 32; drow = n0; }
                src[u] = W + (size_t)(k0 + (lane >> 5)) * N + n0 + (lane & 31); srcN[u] = N;
                dstp[u] = WT + (size_t)(drow + (lane & 31)) * K + k0 + (lane >> 5) * 32;
            }
            float tv[2][32];
#pragma unroll
            for (int u = 0; u < 2; ++u)
#pragma unroll
                for (int i = 0; i < 32; ++i) tv[u][i] = src[u][(size_t)(2 * i) * srcN[u]];
#pragma unroll
            for (int u = 0; u < 2; ++u) {
                if (!valid[u]) break;
                unsigned pk[16];
#pragma unroll
                for (int i = 0; i < 16; ++i) { const u32x2s rr = __builtin_amdgcn_permlane32_swap(__float_as_uint(tv[u][i]), __float_as_uint(tv[u][i + 16]), false, false);
                    pk[i] = cvt_pk_bf16(__uint_as_float(rr.x), __uint_as_float(rr.y)); }
#pragma unroll
                for (int j = 0; j < 4; ++j) *(u32x4*)(dstp[u] + 8 * j) = (u32x4){pk[4 * j], pk[4 * j + 1], pk[4 * j + 2], pk[4 * j + 3]};
            }
        }
    }
}

__device__ __forceinline__ void ln_ctx_rows(const Params& p, int row_lo, int nrows) {
    const int lane = threadIdx.x & 63, wave = threadIdx.x >> 6;
    const float* mv = (const float*)(p.ws + WS_MOD) + 24576; bf16_t* H = (bf16_t*)(p.ws + WS_H);
    for (int r0 = 4 * wave; r0 < nrows; r0 += 32) {
        f32x4 v[4][8]; float rstd[4];
#pragma unroll
        for (int r = 0; r < 4; ++r) { const f32x4* xr = (const f32x4*)(p.ctx + (size_t)(row_lo - T + r0 + r) * D) + lane;
#pragma unroll
            for (int j = 0; j < 8; ++j) v[r][j] = xr[64 * j]; }
#pragma unroll
        for (int r = 0; r < 4; ++r) { float s = 0.f;
#pragma unroll
            for (int j = 0; j < 8; ++j) s += (v[r][j].x + v[r][j].y) + (v[r][j].z + v[r][j].w);
            const float mean = wave_sum(s) * (1.f / D); float s2 = 0.f;
#pragma unroll
            for (int j = 0; j < 8; ++j) { v[r][j] = v[r][j] - mean; s2 += (v[r][j].x * v[r][j].x + v[r][j].y * v[r][j].y) + (v[r][j].z * v[r][j].z + v[r][j].w * v[r][j].w); }
            rstd[r] = 1.f / sqrtf(wave_sum(s2) * (1.f / D) + LN_EPS); }
#pragma unroll
        for (int r = 0; r < 4; ++r) { u32x2* o8 = (u32x2*)(H + (size_t)(row_lo + r0 + r) * D) + lane;
#pragma unroll
            for (int j = 0; j < 8; ++j) { const f32x4 sh = *((const f32x4*)mv + lane + 64 * j), sc = *((const f32x4*)(mv + 2048) + lane + 64 * j);
                const f32x4 h = (v[r][j] * rstd[r]) * (1.f + sc) + sh; u32x2 w; w.x = cvt_pk_bf16(h.x, h.y); w.y = cvt_pk_bf16(h.z, h.w); o8[64 * j] = w; } }
    }
}
__device__ __forceinline__ void phase_ln_in(const Params& p, int row_lo, int row_hi, int gw, int NGW) {
    const int lane = threadIdx.x & 63;
    const float* modv = (const float*)(p.ws + WS_MOD); bf16_t* H = (bf16_t*)(p.ws + WS_H);
    f32x4 SHv[8], SCv[8]; int curm = -1;
#pragma unroll
    for (int j = 0; j < 8; ++j) { SHv[j] = (f32x4){0.f, 0.f, 0.f, 0.f}; SCv[j] = SHv[j]; }
    for (int rowa = row_lo + gw; rowa < row_hi; rowa += 2 * NGW) {
      const int rowb = (rowa + NGW < row_hi) ? rowa + NGW : rowa;
      f32x4 va[8], vb[8];
#pragma unroll
      for (int j = 0; j < 8; ++j) { va[j] = ((const f32x4*)(rowa < T ? p.x + (size_t)rowa * D : p.ctx + (size_t)(rowa - T) * D) + lane)[64 * j];
                                    vb[j] = ((const f32x4*)(rowb < T ? p.x + (size_t)rowb * D : p.ctx + (size_t)(rowb - T) * D) + lane)[64 * j]; }
#pragma unroll
      for (int r = 0; r < 2; ++r) {
        if (r == 1 && rowb == rowa) break;
        const int row = r == 0 ? rowa : rowb;
        const int mrow = row < SEQ ? 0 : row < T ? 1 : 2;
        if (mrow != curm) { curm = mrow; const float* mv = modv + mrow * 12288;
#pragma unroll
            for (int j = 0; j < 8; ++j) { SHv[j] = *((const f32x4*)mv + lane + 64 * j); SCv[j] = 1.f + *((const f32x4*)(mv + 2048) + lane + 64 * j); } }
        f32x4 v[8]; float s = 0.f;
#pragma unroll
        for (int j = 0; j < 8; ++j) { v[j] = r == 0 ? va[j] : vb[j]; s += (v[j].x + v[j].y) + (v[j].z + v[j].w); }
        const float mean = wave_sum(s) * (1.f / D); float s2 = 0.f;
#pragma unroll
        for (int j = 0; j < 8; ++j) { v[j] = v[j] - mean; s2 += (v[j].x * v[j].x + v[j].y * v[j].y) + (v[j].z * v[j].z + v[j].w * v[j].w); }
        const float rstd = 1.f / sqrtf(wave_sum(s2) * (1.f / D) + LN_EPS);
        u32x2* o8 = (u32x2*)(H + (size_t)row * D) + lane;
#pragma unroll
        for (int j = 0; j < 8; ++j) { const f32x4 h = (v[j] * rstd) * SCv[j] + SHv[j]; u32x2 w; w.x = cvt_pk_bf16(h.x, h.y); w.y = cvt_pk_bf16(h.z, h.w); o8[64 * j] = w; }
      }
    }
}

constexpr int L_QH = 0, L_KH = 17408, L_KHT = 34816, L_VT = 53248, L_SC = 71680, L_PART = 80896, L_ER = 84992, L_EBR = 85504;
#define MFMA16(a, b, c) __builtin_amdgcn_mfma_f32_16x16x32_bf16(a, b, c, 0, 0, 0)

#define SCAN_LOADB(GK, VV, QQ, c) do { _Pragma("unroll") for (int j = 0; j < 8; ++j) { const size_t row = (size_t)(r0 + rs * (64 * (c) + 8 * w + j)); \
        GK[j] = *(const unsigned*)(Gp + row * 2048 + gcol + 2 * lane); VV[j] = *(const unsigned*)(Vp + row * 1024 + hcol + 2 * lane); if (OUT) QQ[j] = *(const unsigned*)(Qp + row * 1024 + hcol + 2 * lane); } } while (0)
#define SCAN_BAR() do { asm volatile("s_waitcnt lgkmcnt(0)" ::: "memory"); __builtin_amdgcn_s_barrier(); asm volatile("" ::: "memory"); } while (0)
template <bool OUT>
__device__ __forceinline__ void scan_chunk(unsigned char* lds, const unsigned short* Gp, const bf16_t* Vp, const bf16_t* Qp, bf16_t* Op, int r0, int rs, int c, int cpre, int gcol, int hcol,
                                           f32x4 (&S)[8], f32x2& dtot, unsigned (&gk)[8], unsigned (&vv)[8], unsigned (&qq)[8]) {
    const int tid = threadIdx.x, lane = tid & 63, w = __builtin_amdgcn_readfirstlane(tid >> 6), fr = lane & 15, q = lane >> 4;
    float* PART = (float*)(lds + L_PART); float* ER = (float*)(lds + L_ER); float* EBR = (float*)(lds + L_EBR);
    {
        f32x2 kf[8], loc[8]; f32x2 run = {1.f, 1.f};
#pragma unroll
        for (int j = 0; j < 8; ++j) { const h16x2 kk = __builtin_bit_cast(h16x2, gk[j]); kf[j] = (f32x2){(float)kk.x, (float)kk.y}; }
        if (w >= 4) {
#pragma unroll
            for (int j = 0; j < 8; ++j) { run *= 1.f - kf[j]; loc[j] = run; }
        } else {
#pragma unroll
            for (int j = 7; j >= 0; --j) { loc[j] = run; run *= 1.f - kf[j]; }
        }
        *(f32x2*)(PART + w * 128 + 2 * lane) = run;
        SCAN_BAR();
        {
            f32x2 pv[8];
#pragma unroll
            for (int o = 0; o < 8; ++o) pv[o] = *(const f32x2*)(PART + o * 128 + 2 * lane);
            f32x2 fac = {1.f, 1.f};
#pragma unroll
            for (int o = 0; o < 8; ++o) { const bool use = (w >= 4) ? (o >= 4 && o < w) : (o > w && o <= 3); if (use) fac *= pv[o]; }
            f32x2 kh[8];
#pragma unroll
            for (int j = 0; j < 8; ++j) {
                const f32x2 m = loc[j] * fac; const f32x2 inv = {__builtin_amdgcn_rcpf(m.x), __builtin_amdgcn_rcpf(m.y)};
                kh[j] = kf[j] * (w >= 4 ? inv : m);
                if (OUT) {
                    const f32x2 e1 = w >= 4 ? m : inv;
                    const unsigned qp = cvt_pk_bf16(__uint_as_float(qq[j] << 16) * e1.x, __uint_as_float(qq[j] & 0xffff0000u) * e1.y);
                    const int i = 8 * w + j;
                    *(unsigned*)(lds + L_QH + i * 272 + 4 * lane) = qp;
                    *(unsigned*)(lds + L_KH + i * 272 + 4 * lane) = cvt_pk_bf16(kh[j].x, kh[j].y);
                }
            }
            *(u32x4*)(lds + L_KHT + (2 * lane) * 144 + 16 * w) = (u32x4){cvt_pk_bf16(kh[0].x, kh[1].x), cvt_pk_bf16(kh[2].x, kh[3].x), cvt_pk_bf16(kh[4].x, kh[5].x), cvt_pk_bf16(kh[6].x, kh[7].x)};
            *(u32x4*)(lds + L_KHT + (2 * lane + 1) * 144 + 16 * w) = (u32x4){cvt_pk_bf16(kh[0].y, kh[1].y), cvt_pk_bf16(kh[2].y, kh[3].y), cvt_pk_bf16(kh[4].y, kh[5].y), cvt_pk_bf16(kh[6].y, kh[7].y)};
            *(u32x4*)(lds + L_VT + (2 * lane) * 144 + 16 * w) = (u32x4){__builtin_amdgcn_perm(vv[1], vv[0], 0x05040100u), __builtin_amdgcn_perm(vv[3], vv[2], 0x05040100u), __builtin_amdgcn_perm(vv[5], vv[4], 0x05040100u), __builtin_amdgcn_perm(vv[7], vv[6], 0x05040100u)};
            *(u32x4*)(lds + L_VT + (2 * lane + 1) * 144 + 16 * w) = (u32x4){__builtin_amdgcn_perm(vv[1], vv[0], 0x07060302u), __builtin_amdgcn_perm(vv[3], vv[2], 0x07060302u), __builtin_amdgcn_perm(vv[5], vv[4], 0x07060302u), __builtin_amdgcn_perm(vv[7], vv[6], 0x07060302u)};
            if (w == 0) { const f32x2 er = (pv[0] * pv[1]) * (pv[2] * pv[3]), ebr = (pv[4] * pv[5]) * (pv[6] * pv[7]); *(f32x2*)(ER + 2 * lane) = er; *(f32x2*)(EBR + 2 * lane) = ebr;
                dtot += (f32x2){__logf(er.x) + __logf(ebr.x), __logf(er.y) + __logf(ebr.y)}; }
        }
        if (cpre >= 0) SCAN_LOADB(gk, vv, qq, cpre);
        SCAN_BAR();
#pragma unroll
        for (int kt = 0; kt < 8; ++kt) S[kt] *= *(const f32x4*)(ER + 16 * kt + 4 * q);
        f32x4 oacc[4];
        if (OUT) {
            bf16x8 Sb[4];
#pragma unroll
            for (int m = 0; m < 4; ++m) { u32x4 t; t.x = cvt_pk_bf16(S[2 * m][0], S[2 * m][1]); t.y = cvt_pk_bf16(S[2 * m][2], S[2 * m][3]); t.z = cvt_pk_bf16(S[2 * m + 1][0], S[2 * m + 1][1]); t.w = cvt_pk_bf16(S[2 * m + 1][2], S[2 * m + 1][3]);
                Sb[m] = __builtin_bit_cast(bf16x8, t); }
#pragma unroll
            for (int tb = 0; tb < 4; ++tb) { oacc[tb] = (f32x4){0.f, 0.f, 0.f, 0.f};
#pragma unroll
                for (int m = 0; m < 4; ++m) { const unsigned char* qa = lds + L_QH + (16 * tb + fr) * 272 + (32 * m + 4 * q) * 2;
                    const u32x2 lo = *(const u32x2*)qa, hi = *(const u32x2*)(qa + 32);
                    const bf16x8 qf = __builtin_bit_cast(bf16x8, ((u32x4){lo.x, lo.y, hi.x, hi.y}));
                    oacc[tb] = MFMA16(Sb[m], qf, oacc[tb]); } }
            const int tb = w >> 1;
#pragma unroll
            for (int sbi = 0; sbi < 2; ++sbi) { const int sb = 2 * (w & 1) + sbi; f32x4 a = {0.f, 0.f, 0.f, 0.f};
                if (sb <= tb) {
#pragma unroll
                    for (int m = 0; m < 4; ++m) { const bf16x8 ka = *(const bf16x8*)(lds + L_KH + (16 * sb + fr) * 272 + (32 * m + 8 * q) * 2), qb = *(const bf16x8*)(lds + L_QH + (16 * tb + fr) * 272 + (32 * m + 8 * q) * 2);
                        a = MFMA16(ka, qb, a); }
                    const int tabs = 16 * tb + fr, s0 = 16 * sb + 4 * q;
#pragma unroll
                    for (int j = 0; j < 4; ++j) a[j] = (s0 + j <= tabs) ? a[j] : 0.f;
                }
                u32x2 wv; wv.x = cvt_pk_bf16(a[0], a[1]); wv.y = cvt_pk_bf16(a[2], a[3]);
                *(u32x2*)(lds + L_SC + (16 * tb + fr) * 144 + (16 * sb + 4 * q) * 2) = wv; }
            SCAN_BAR();
        }
        bf16x8 Vf[2];
#pragma unroll
        for (int n = 0; n < 2; ++n) Vf[n] = *(const bf16x8*)(lds + L_VT + (16 * w + fr) * 144 + (32 * n + 8 * q) * 2);
        if (OUT) {
#pragma unroll
            for (int tb = 0; tb < 4; ++tb) {
#pragma unroll
                for (int n = 0; n < 2; ++n) { const bf16x8 sf = *(const bf16x8*)(lds + L_SC + (16 * tb + fr) * 144 + (32 * n + 8 * q) * 2); oacc[tb] = MFMA16(Vf[n], sf, oacc[tb]); }
                const size_t row = (size_t)(r0 + rs * (64 * c + 16 * tb + fr));
                u32x2 wv; wv.x = cvt_pk_bf16(oacc[tb][0], oacc[tb][1]); wv.y = cvt_pk_bf16(oacc[tb][2], oacc[tb][3]);
                *(u32x2*)(Op + row * 1024 + hcol + 16 * w + 4 * q) = wv; }
        }
#pragma unroll
        for (int kt = 0; kt < 8; ++kt) {
#pragma unroll
            for (int n = 0; n < 2; ++n) { const bf16x8 kf = *(const bf16x8*)(lds + L_KHT + (16 * kt + fr) * 144 + (32 * n + 8 * q) * 2); S[kt] = MFMA16(kf, Vf[n], S[kt]); }
            S[kt] *= *(const f32x4*)(EBR + 16 * kt + 4 * q); }
    }
}
template <bool OUT>
__device__ __forceinline__ void scan_run(unsigned char* lds, const unsigned short* Gp, const bf16_t* Vp, const bf16_t* Qp, bf16_t* Op,
                                         int r0, int rs, int chunk0, int nchunks, int gcol, int hcol, f32x4 (&S)[8], f32x2& dtot) {
    const int lane = threadIdx.x & 63, w = __builtin_amdgcn_readfirstlane(threadIdx.x >> 6);
    constexpr int GR = OUT ? 2 : 4;
    unsigned gk[GR][8], vv[GR][8], qq[GR][8];
    const int end = chunk0 + nchunks;
#pragma unroll
    for (int g = 0; g < GR; ++g) SCAN_LOADB(gk[g], vv[g], qq[g], chunk0 + g);
    for (int c = chunk0; c < end; c += GR) {
#pragma unroll
        for (int g = 0; g < GR; ++g) scan_chunk<OUT>(lds, Gp, Vp, Qp, Op, r0, rs, c + g, (c + g + GR < end) ? c + g + GR : -1, gcol, hcol, S, dtot, gk[g], vv[g], qq[g]);
    }
    __syncthreads();
}
#undef SCAN_LOADB
#undef SCAN_BAR

__device__ __forceinline__ void phase_scan1(const Params& p, unsigned char* lds) {
    const int tid = threadIdx.x, lane = tid & 63, w = tid >> 6;
    const unsigned short* Gp = (const unsigned short*)(p.ws + WS_G); const bf16_t* Vp = (const bf16_t*)(p.ws + WS_V);
    for (int item = blockIdx.x; item < 256; item += gridDim.x) {
        const int seq = item >> 3, seg = item & 7, dir = seq >> 4, b = (seq >> 3) & 1, h = seq & 7;
        f32x4 S[8];
#pragma unroll
        for (int kt = 0; kt < 8; ++kt) S[kt] = (f32x4){0.f, 0.f, 0.f, 0.f};
        f32x2 dtot = {0.f, 0.f};
        if (seg < 7) scan_run<false>(lds, Gp, Vp, nullptr, nullptr, dir ? b * SEQ + SEQ - 1 : b * SEQ, dir ? -1 : 1, seg * 32, 32, dir * 1024 + h * 128, h * 128, S, dtot);
        else scan_run<false>(lds, Gp, Vp, nullptr, nullptr, dir ? T + b * CTXL + CTXL - 1 : T + b * CTXL, dir ? -1 : 1, 0, 4, dir * 1024 + h * 128, h * 128, S, dtot);
        float* dst = (float*)(p.ws + WS_SEG) + ((size_t)(seq * 8 + seg) * 8 + w) * 2048;
#pragma unroll
        for (int kt = 0; kt < 8; ++kt)
#pragma unroll
            for (int j = 0; j < 4; ++j) dst[(kt * 4 + j) * 64 + lane] = S[kt][j];
        if (w == 0) *(f32x2*)((float*)(p.ws + WS_SEGDEC) + (seq * 8 + seg) * 128 + 2 * lane) = dtot;
    }
}
__device__ __forceinline__ void phase_scan2(const Params& p, unsigned char* lds) {
    const int tid = threadIdx.x, lane = tid & 63, w = tid >> 6, q = lane >> 4;
    const unsigned short* Gp = (const unsigned short*)(p.ws + WS_G); const bf16_t* Vp = (const bf16_t*)(p.ws + WS_V); const bf16_t* Qp = (const bf16_t*)(p.ws + WS_Q);
    for (int item = blockIdx.x; item < 256; item += gridDim.x) {
        const int seq = item >> 3, seg = item & 7, dir = seq >> 4, b = (seq >> 3) & 1, h = seq & 7;
        f32x4 S[8];
        const float* segb = (const float*)(p.ws + WS_SEG) + ((size_t)(seq * 8) * 8 + w) * 2048; const float* decb = (const float*)(p.ws + WS_SEGDEC) + (seq * 8) * 128;
#pragma unroll
        for (int kt = 0; kt < 8; ++kt)
#pragma unroll
            for (int j = 0; j < 4; ++j) S[kt][j] = segb[(size_t)7 * 8 * 2048 + (kt * 4 + j) * 64 + lane];
        int s = 0;
        for (; s + 1 < seg; s += 2) {
            f32x4 La[8], Lb[8], Da[8], Db[8];
#pragma unroll
            for (int kt = 0; kt < 8; ++kt) { Da[kt] = *(const f32x4*)(decb + s * 128 + 16 * kt + 4 * q); Db[kt] = *(const f32x4*)(decb + (s + 1) * 128 + 16 * kt + 4 * q);
#pragma unroll
                for (int j = 0; j < 4; ++j) { La[kt][j] = segb[(size_t)s * 8 * 2048 + (kt * 4 + j) * 64 + lane]; Lb[kt][j] = segb[(size_t)(s + 1) * 8 * 2048 + (kt * 4 + j) * 64 + lane]; } }
#pragma unroll
            for (int kt = 0; kt < 8; ++kt)
#pragma unroll
                for (int j = 0; j < 4; ++j) S[kt][j] = __expf(Db[kt][j]) * (__expf(Da[kt][j]) * S[kt][j] + La[kt][j]) + Lb[kt][j];
        }
        if (s < seg) {
#pragma unroll
            for (int kt = 0; kt < 8; ++kt)
#pragma unroll
                for (int j = 0; j < 4; ++j) S[kt][j] = __expf(decb[s * 128 + 16 * kt + 4 * q + j]) * S[kt][j] + segb[(size_t)s * 8 * 2048 + (kt * 4 + j) * 64 + lane];
        }
        f32x2 dtot = {0.f, 0.f};
        bf16_t* Op = (bf16_t*)(p.ws + WS_O) + (size_t)dir * T * HW;
        scan_run<true>(lds, Gp, Vp, Qp, Op, dir ? b * SEQ + SEQ - 1 : b * SEQ, dir ? -1 : 1, seg * 32, 32, dir * 1024 + h * 128, h * 128, S, dtot);
    }
}

__device__ __forceinline__ void phase_combine(const Params& p) {
    const int lane = threadIdx.x & 63, gw = blockIdx.x * 8 + (threadIdx.x >> 6), NGW = gridDim.x * 8;
    const bf16_t* Of = (const bf16_t*)(p.ws + WS_O); const bf16_t* Ob = Of + (size_t)T * HW; const bf16_t* GT = (const bf16_t*)(p.ws + WS_GATE);
    const bf16_t* BG = (const bf16_t*)(p.ws + WS_BG); const bf16_t* P = (const bf16_t*)(p.ws + WS_P); bf16_t* Y = (bf16_t*)(p.ws + WS_Y);
    const int c0 = 16 * lane;
    {
        float gw_[16];
#pragma unroll
        for (int j = 0; j < 16; ++j) gw_[j] = p.g_norm_w[(c0 + j) & 127];
        u32x4 a[2][2], b[2][2], g[2][2], na[2][2], nb[2][2], ng[2][2];
#define HG_LOAD(A_, B_, G_, tk0) do { _Pragma("unroll") for (int u = 0; u < 2; ++u) { const int tk_ = ((tk0) + u * NGW < T) ? (tk0) + u * NGW : gw; \
            _Pragma("unroll") for (int i = 0; i < 2; ++i) { const size_t off = (size_t)tk_ * 1024 + c0 + 8 * i; A_[u][i] = *(const u32x4*)(Of + off); B_[u][i] = *(const u32x4*)(Ob + off); G_[u][i] = *(const u32x4*)(GT + off); } } } while (0)
        HG_LOAD(a, b, g, gw);
#pragma unroll
        for (int u = 0; u < 2; ++u)
#pragma unroll
            for (int i = 0; i < 2; ++i) { na[u][i] = a[u][i]; nb[u][i] = b[u][i]; ng[u][i] = g[u][i]; }
        for (int tok0 = gw; tok0 < T; tok0 += 2 * NGW) {
            if (tok0 + 2 * NGW < T) HG_LOAD(na, nb, ng, tok0 + 2 * NGW);
#pragma unroll
            for (int u = 0; u < 2; ++u) {
                const int tok = tok0 + u * NGW; if (tok >= T) break;
                float o[16], gt[16]; float ss = 0.f;
#pragma unroll
                for (int i = 0; i < 2; ++i)
#pragma unroll
                    for (int j = 0; j < 4; ++j) { const unsigned ua = a[u][i][j], ub = b[u][i][j], ug = g[u][i][j];
                        const float lo = __uint_as_float(ua << 16) + __uint_as_float(ub << 16), hi = __uint_as_float(ua & 0xffff0000u) + __uint_as_float(ub & 0xffff0000u);
                        o[8 * i + 2 * j] = lo; o[8 * i + 2 * j + 1] = hi; ss += lo * lo + hi * hi; gt[8 * i + 2 * j] = silu_f(__uint_as_float(ug << 16)); gt[8 * i + 2 * j + 1] = silu_f(__uint_as_float(ug & 0xffff0000u)); }
                ss += __shfl_xor(ss, 1); ss += __shfl_xor(ss, 2); ss += __shfl_xor(ss, 4);
                const float rstd = 1.f / sqrtf(ss * (1.f / 128.f) + RMS_EPS);
                u32x4 w[2];
#pragma unroll
                for (int i = 0; i < 2; ++i)
#pragma unroll
                    for (int j = 0; j < 4; ++j) w[i][j] = cvt_pk_bf16(o[8 * i + 2 * j] * rstd * gw_[8 * i + 2 * j] * gt[8 * i + 2 * j], o[8 * i + 2 * j + 1] * rstd * gw_[8 * i + 2 * j + 1] * gt[8 * i + 2 * j + 1]);
                bf16_t* yr = Y + (size_t)tok * D + c0;
                *(u32x4*)yr = w[0]; *(u32x4*)(yr + 8) = w[1];
            }
#pragma unroll
            for (int u = 0; u < 2; ++u)
#pragma unroll
                for (int i = 0; i < 2; ++i) { a[u][i] = na[u][i]; b[u][i] = nb[u][i]; g[u][i] = ng[u][i]; }
        }
#undef HG_LOAD
    }
    {
        float cw0[16], cw1[16], cw2[16];
#pragma unroll
        for (int j = 0; j < 16; ++j) { cw0[j] = p.conv_w[c0 + j]; cw1[j] = p.conv_w[1024 + c0 + j]; cw2[j] = p.conv_w[2048 + c0 + j]; }
        u32x4 pc[2][2], pp[2][2], pn[2][2], bg[2][2], npc[2][2], npp[2][2], npn[2][2], nbg[2][2];
#define CONV_LOAD(tk0, PC, PP, PN, BGv) do { _Pragma("unroll") for (int u = 0; u < 2; ++u) { const int tk_ = ((tk0) + u * NGW < T) ? (tk0) + u * NGW : gw; \
            const int tt_ = tk_ & 63; const bool hp_ = tt_ != 0, hn_ = tt_ != 63; _Pragma("unroll") for (int i = 0; i < 2; ++i) { const size_t off = (size_t)tk_ * 1024 + c0 + 8 * i; \
            PC[u][i] = *(const u32x4*)(P + off); BGv[u][i] = *(const u32x4*)(BG + off); PP[u][i] = hp_ ? *(const u32x4*)(P + off - 1024) : (u32x4){0, 0, 0, 0}; PN[u][i] = hn_ ? *(const u32x4*)(P + off + 1024) : (u32x4){0, 0, 0, 0}; } } } while (0)
        CONV_LOAD(gw, pc, pp, pn, bg);
#pragma unroll
        for (int u = 0; u < 2; ++u)
#pragma unroll
            for (int i = 0; i < 2; ++i) { npc[u][i] = pc[u][i]; npp[u][i] = pp[u][i]; npn[u][i] = pn[u][i]; nbg[u][i] = bg[u][i]; }
        for (int tok0 = gw; tok0 < T; tok0 += 2 * NGW) {
            if (tok0 + 2 * NGW < T) CONV_LOAD(tok0 + 2 * NGW, npc, npp, npn, nbg);
#pragma unroll
            for (int u = 0; u < 2; ++u) {
                const int tok = tok0 + u * NGW; if (tok >= T) break;
                u32x4 w[2];
#pragma unroll
                for (int i = 0; i < 2; ++i)
#pragma unroll
                    for (int j = 0; j < 4; ++j) { const int e = 8 * i + 2 * j;
                        const float lo = __uint_as_float(bg[u][i][j] << 16) * (cw0[e] * __uint_as_float(pp[u][i][j] << 16) + cw1[e] * __uint_as_float(pc[u][i][j] << 16) + cw2[e] * __uint_as_float(pn[u][i][j] << 16));
                        const float hi = __uint_as_float(bg[u][i][j] & 0xffff0000u) * (cw0[e + 1] * __uint_as_float(pp[u][i][j] & 0xffff0000u) + cw1[e + 1] * __uint_as_float(pc[u][i][j] & 0xffff0000u) + cw2[e + 1] * __uint_as_float(pn[u][i][j] & 0xffff0000u));
                        w[i][j] = cvt_pk_bf16(lo, hi); }
                bf16_t* yr = Y + (size_t)tok * D + 1024 + c0;
                *(u32x4*)yr = w[0]; *(u32x4*)(yr + 8) = w[1];
            }
#pragma unroll
            for (int u = 0; u < 2; ++u)
#pragma unroll
                for (int i = 0; i < 2; ++i) { pc[u][i] = npc[u][i]; pp[u][i] = npp[u][i]; pn[u][i] = npn[u][i]; bg[u][i] = nbg[u][i]; }
        }
#undef CONV_LOAD
    }
}

#define LNH_STATS(v, mean, rstd) do { float s_ = 0.f; \
        _Pragma("unroll") for (int j = 0; j < 4; ++j) _Pragma("unroll") for (int e = 0; e < 8; e += 2) s_ += v[j][e] + v[j][e + 1]; \
        mean = wave_sum(s_) * (1.f / D); float s2_ = 0.f; \
        _Pragma("unroll") for (int j = 0; j < 4; ++j) _Pragma("unroll") for (int e = 0; e < 8; ++e) { v[j][e] -= mean; s2_ += v[j][e] * v[j][e]; } \
        rstd = 1.f / sqrtf(wave_sum(s2_) * (1.f / D) + LN_EPS); } while (0)
__device__ __forceinline__ void phase_ln_mid(const Params& p) {
    const int lane = threadIdx.x & 63, gw = blockIdx.x * 8 + (threadIdx.x >> 6), NGW = gridDim.x * 8;
    const float* modv = (const float*)(p.ws + WS_MOD); bf16_t* H = (bf16_t*)(p.ws + WS_H); const unsigned short* U1 = (const unsigned short*)(p.ws + WS_U1); float* stats = (float*)(p.ws + WS_STATS);
    f32x4 G1[4][2], B1[4][2];
#pragma unroll
    for (int j = 0; j < 4; ++j)
#pragma unroll
        for (int h = 0; h < 2; ++h) { const int c = 8 * (lane + 64 * j) + 4 * h; G1[j][h] = *(const f32x4*)(p.ln1_g + c); B1[j][h] = *(const f32x4*)(p.ln1_b + c); }
    for (int row0 = gw; row0 < T; row0 += 2 * NGW) {
        const int row1 = (row0 + NGW < T) ? row0 + NGW : row0;
        u32x4 ra[4], rb[4];
#pragma unroll
        for (int j = 0; j < 4; ++j) { ra[j] = ((const u32x4*)(U1 + (size_t)row0 * D) + lane)[64 * j]; rb[j] = ((const u32x4*)(U1 + (size_t)row1 * D) + lane)[64 * j]; }
#pragma unroll
        for (int r = 0; r < 2; ++r) {
            if (r == 1 && row1 == row0) break;
            const int row = r == 0 ? row0 : row1;
            const float* mv = modv + (row < SEQ ? 0 : 12288);
            float v[4][8];
#pragma unroll
            for (int j = 0; j < 4; ++j) unpack_h8(r == 0 ? ra[j] : rb[j], v[j]);
            float mean, rstd; LNH_STATS(v, mean, rstd);
            if (lane == 0) *(f32x2*)(stats + 2 * row) = (f32x2){mean, rstd};
#pragma unroll
            for (int j = 0; j < 4; ++j) { const int c = 8 * (lane + 64 * j);
#pragma unroll
                for (int h = 0; h < 2; ++h) { const f32x4 g = G1[j][h], bb = B1[j][h];
#pragma unroll
                    for (int e = 0; e < 4; ++e) v[j][4 * h + e] = (v[j][4 * h + e] * rstd) * g[e] + bb[e]; } }
            float mean2, rstd2; LNH_STATS(v, mean2, rstd2);
            u32x4* o16 = (u32x4*)(H + (size_t)row * D) + lane;
#pragma unroll
            for (int j = 0; j < 4; ++j) { const int c = 8 * (lane + 64 * j); float hh[8];
#pragma unroll
                for (int h = 0; h < 2; ++h) { const f32x4 sh = *(const f32x4*)(mv + 3 * 2048 + c + 4 * h), sc = *(const f32x4*)(mv + 4 * 2048 + c + 4 * h);
#pragma unroll
                    for (int e = 0; e < 4; ++e) hh[4 * h + e] = (v[j][4 * h + e] * rstd2) * (1.f + sc[e]) + sh[e]; }
                u32x4 w; w.x = cvt_pk_bf16(hh[0], hh[1]); w.y = cvt_pk_bf16(hh[2], hh[3]); w.z = cvt_pk_bf16(hh[4], hh[5]); w.w = cvt_pk_bf16(hh[6], hh[7]); o16[64 * j] = w; }
        }
    }
}
__device__ __forceinline__ void phase_ln_out(const Params& p) {
    const int lane = threadIdx.x & 63, gw = blockIdx.x * 8 + (threadIdx.x >> 6), NGW = gridDim.x * 8;
    const unsigned short* U2 = (const unsigned short*)(p.ws + WS_H);
    f32x4 G2[4][2], B2[4][2];
#pragma unroll
    for (int j = 0; j < 4; ++j)
#pragma unroll
        for (int h = 0; h < 2; ++h) { const int c = 8 * (lane + 64 * j) + 4 * h; G2[j][h] = *(const f32x4*)(p.ln2_g + c); B2[j][h] = *(const f32x4*)(p.ln2_b + c); }
    for (int row0 = gw; row0 < T; row0 += 2 * NGW) {
        const int row1 = (row0 + NGW < T) ? row0 + NGW : row0;
        u32x4 ra[4], rb[4];
#pragma unroll
        for (int j = 0; j < 4; ++j) { ra[j] = ((const u32x4*)(U2 + (size_t)row0 * D) + lane)[64 * j]; rb[j] = ((const u32x4*)(U2 + (size_t)row1 * D) + lane)[64 * j]; }
#pragma unroll
        for (int r = 0; r < 2; ++r) {
            if (r == 1 && row1 == row0) break;
            float v[4][8];
#pragma unroll
            for (int j = 0; j < 4; ++j) unpack_h8(r == 0 ? ra[j] : rb[j], v[j]);
            float mean, rstd; LNH_STATS(v, mean, rstd);
            float* orow = p.out + (size_t)(r == 0 ? row0 : row1) * D;
#pragma unroll
            for (int j = 0; j < 4; ++j) { const int c = 8 * (lane + 64 * j);
#pragma unroll
                for (int h = 0; h < 2; ++h) { const f32x4 g = G2[j][h], bb = B2[j][h]; f32x4 o;
#pragma unroll
                    for (int e = 0; e < 4; ++e) o[e] = (v[j][4 * h + e] * rstd) * g[e] + bb[e];
                    *(f32x4*)(orow + c + 4 * h) = o; } }
        }
    }
}

__global__ void __launch_bounds__(512, 2) hymba_fwd(Params p) {
    extern __shared__ __attribute__((aligned(16))) unsigned char shm[];
    cg::grid_group grid = cg::this_grid();
    PG8_LAS unsigned char* lds3 = (PG8_LAS unsigned char*)shm;
    const int lo = p.lo, hi = p.hi;
#define IN(k) (lo <= (k) && (k) < hi)
    if (threadIdx.x == 0) { *(volatile PG8_LAS unsigned*)(lds3 + pg8::STAGE_BYTES) = 0u; *(volatile PG8_LAS unsigned*)(lds3 + pg8::STAGE_BYTES + 4) = 0u; }
    __syncthreads();
    XcdBarrier xbar = xcd_barrier_post((unsigned*)(p.ws + WS_BAR), (volatile PG8_LAS unsigned*)(lds3 + pg8::STAGE_BYTES));
    if (lo < 0) grid.sync();
#define SEAM(k) do { if ((k) + 1 < hi) xcd_barrier(xbar); } while (0)
    if (IN(0)) { phase_prep(p, shm); SEAM(0); }
    if (IN(1)) {
        const int NCW = (gridDim.x >= 64) ? 24 : 0;
        if ((int)blockIdx.x < NCW) {
            const int cb = (int)blockIdx.x / 12, cpn = (int)blockIdx.x % 12;
            ln_ctx_rows(p, T + cb * CTXL, CTXL);
            asm volatile("s_waitcnt vmcnt(0)" ::: "memory"); __syncthreads();
            pg8::Gemm g{(const bf16_t*)(p.ws + WS_H), (const bf16_t*)(p.ws + WS_WIN), TALL, NIN, D}; OneUnit S1{T / 256 + cb, cpn};
            EpiIn E{(unsigned short*)(p.ws + WS_G), (bf16_t*)(p.ws + WS_V), (bf16_t*)(p.ws + WS_Q), (bf16_t*)(p.ws + WS_GATE), (bf16_t*)(p.ws + WS_BG), (bf16_t*)(p.ws + WS_P), (const float*)(p.ws + WS_LB)};
            pg8::gemm_phase<EpiIn, OneUnit>(lds3, g, S1, E);
        } else {
            if (NCW == 0) phase_ln_in(p, T, TALL, (int)(blockIdx.x * 8 + (threadIdx.x >> 6)), (int)gridDim.x * 8);
            phase_ln_in(p, 0, T, (int)((blockIdx.x - NCW) * 8 + (threadIdx.x >> 6)), (int)(gridDim.x - NCW) * 8);
        }
        SEAM(1);
    }
    if (IN(2)) {
        const int Min = (gridDim.x >= 64) ? T : TALL;
        pg8::Gemm g{(const bf16_t*)(p.ws + WS_H), (const bf16_t*)(p.ws + WS_WIN), Min, NIN, D}; pg8::StaticOrder S; S.init(Min, NIN, (int)gridDim.x, (int)blockIdx.x);
        EpiIn E{(unsigned short*)(p.ws + WS_G), (bf16_t*)(p.ws + WS_V), (bf16_t*)(p.ws + WS_Q), (bf16_t*)(p.ws + WS_GATE), (bf16_t*)(p.ws + WS_BG), (bf16_t*)(p.ws + WS_P), (const float*)(p.ws + WS_LB)};
        pg8::gemm_phase<EpiIn, pg8::StaticOrder>(lds3, g, S, E); SEAM(2);
    }
    if (IN(3)) { phase_scan1(p, shm); SEAM(3); }
    if (IN(4)) { phase_scan2(p, shm); SEAM(4); }
    if (IN(5)) { phase_combine(p); SEAM(5); }
    if (IN(6)) {
        pg8::Gemm g{(const bf16_t*)(p.ws + WS_Y), (const bf16_t*)(p.ws + WS_WOUT), T, D, D}; pg8::StaticOrder S; S.init(T, D, (int)gridDim.x, (int)blockIdx.x);
        EpiOut E{p.x, (const float*)(p.ws + WS_MOD), (unsigned short*)(p.ws + WS_U1)};
        pg8::gemm_phase<EpiOut, pg8::StaticOrder>(lds3, g, S, E); SEAM(6);
    }
    if (IN(7)) { phase_ln_mid(p); SEAM(7); }
    if (IN(8)) {
        pg8::Gemm g{(const bf16_t*)(p.ws + WS_H), (const bf16_t*)(p.ws + WS_WGU), T, NGU, D}; pg8::StaticOrder S; S.init(T, NGU, (int)gridDim.x, (int)blockIdx.x);
        EpiGU E{(bf16_t*)(p.ws + WS_HID)};
        pg8::gemm_phase<EpiGU, pg8::StaticOrder>(lds3, g, S, E); SEAM(8);
    }
    if (IN(9)) {
        pg8::Gemm g{(const bf16_t*)(p.ws + WS_HID), (const bf16_t*)(p.ws + WS_WDN), T, D, DFF}; pg8::StaticOrder S; S.init(T, D, (int)gridDim.x, (int)blockIdx.x);
        EpiDown E{(const unsigned short*)(p.ws + WS_U1), (const float*)(p.ws + WS_STATS), (const float*)(p.ws + WS_MOD), p.ln1_g, p.ln1_b, (unsigned short*)(p.ws + WS_H)};
        pg8::gemm_phase<EpiDown, pg8::StaticOrder>(lds3, g, S, E); SEAM(9);
    }
    if (IN(10)) { phase_ln_out(p); }
#undef IN
#undef SEAM
}

extern "C" void kernel_launch(void* const* d_in, const int* in_sizes, int n_in, void* d_out, int out_size, void* d_ws, size_t ws_size, hipStream_t stream) {
    constexpr int LDS_BYTES = pg8::STAGE_BYTES + 16;
    static int grid = 0;
    if (grid == 0) {
        if (n_in != 18 || ws_size < WS_END) { fprintf(stderr, "kernel_launch: unexpected inputs (n_in %d, ws %zu < %zu)\n", n_in, ws_size, (size_t)WS_END); grid = -1; return; }
        int dev = 0, cus = 0, per_cu = 0;
        (void)hipGetDevice(&dev); (void)hipDeviceGetAttribute(&cus, hipDeviceAttributeMultiprocessorCount, dev);
        if (hipFuncSetAttribute((const void*)hymba_fwd, hipFuncAttributeMaxDynamicSharedMemorySize, LDS_BYTES) != hipSuccess) { fprintf(stderr, "kernel_launch: hipFuncSetAttribute failed\n"); grid = -1; return; }
        if (hipOccupancyMaxActiveBlocksPerMultiprocessor(&per_cu, (const void*)hymba_fwd, 512, LDS_BYTES) != hipSuccess || per_cu < 1) { fprintf(stderr, "kernel_launch: occupancy query says %d\n", per_cu); per_cu = 1; }
        (void)hipGetLastError();
        grid = cus * 1;
    }
    if (grid < 0) return;
    if (hipMemsetAsync((char*)d_ws + WS_BAR, 0, 16384, stream) != hipSuccess) { fprintf(stderr, "kernel_launch: memset of the barrier words failed\n"); return; }
    Params p{};
    const float** pp = (const float**)&p;
    for (int i = 0; i < 18; ++i) pp[i] = (const float*)d_in[i];
    p.out = (float*)d_out; p.ws = (unsigned char*)d_ws;
#if ONE_LAUNCH
    p.lo = 0; p.hi = 11;
    void* args[] = {&p};
    hipError_t e = hipLaunchCooperativeKernel((const void*)hymba_fwd, dim3(grid), dim3(512), args, LDS_BYTES, stream);
    if (e != hipSuccess) fprintf(stderr, "cooperative launch failed: %s (grid %d)\n", hipGetErrorString(e), grid);
#else
    for (int k = 0; k < 11; ++k) { p.lo = k; p.hi = k + 1; hipLaunchKernelGGL(hymba_fwd, dim3(grid), dim3(512), LDS_BYTES, stream, p); }
#endif
}
```
